# Optimizing an MI355X kernel written in HIP

```python
import jax, jax.numpy as jnp
from jax import lax
import numpy as np

D_MODEL = 2048
BATCH = 4
SEQ = 4096
DEPTH = 2

GRID_W = 64
CTX_LEN = 256
N_EVEN = (DEPTH + 1) // 2
N_ODD = DEPTH // 2
N_MOD = 6
MIX_W = D_MODEL
GLA_HEADS = 4
GLA_VAL_W = MIX_W // 2
GLA_KEY_W = GLA_VAL_W // 2
GLA_DK = GLA_KEY_W // GLA_HEADS
GLA_DV = GLA_VAL_W // GLA_HEADS
GLA_GATE_RANK = 16
GLA_GATE_TAU = 16.0
GLA_CHUNK = 64
LRU_W = MIX_W - GLA_VAL_W
LRU_BLOCKS = 8
LRU_BW = LRU_W // LRU_BLOCKS
LRU_CONV_W = 4
LRU_C = 8.0
IN_EVEN = 2 * GLA_KEY_W + 2 * GLA_VAL_W + 2 * GLA_GATE_RANK + 2 * LRU_W
NA_HEADS = 16
NA_HD = D_MODEL // NA_HEADS
NA_WIN_ROWS = 8
NA_WIN_COLS = 16
D_FF = 4 * D_MODEL
ROPE_BASE = 10000.0
EPS = 1e-6

kernel_name = "hybrid_gla_rglru_natten_dit"

F32 = jnp.float32


def rms_norm(x, g):
    xf = x.astype(F32)
    y = xf * lax.rsqrt(jnp.mean(xf * xf, axis=-1, keepdims=True) + EPS)
    return (y * g.astype(F32)).astype(x.dtype)


def modulate(x, g, shift, scale):
    return rms_norm(x, g) * (1 + scale) + shift


def axial_rope(x):
    n_tok, d = x.shape[1], x.shape[-1]
    d_axis = d // 2
    n_freq = d_axis // 2
    inv_freq = ROPE_BASE ** (-jnp.arange(n_freq, dtype=F32) / n_freq)
    t = jnp.arange(n_tok)
    row = (t // GRID_W).astype(F32)
    col = (t % GRID_W).astype(F32)

    def rot(xh, pos):
        ang = pos[:, None] * inv_freq[None, :]
        cos = jnp.cos(ang)[None, :, None, :]
        sin = jnp.sin(ang)[None, :, None, :]
        x1, x2 = xh[..., :n_freq], xh[..., n_freq:]
        return jnp.concatenate([x1 * cos - x2 * sin, x1 * sin + x2 * cos], axis=-1)

    xf = x.astype(F32)
    out = jnp.concatenate([rot(xf[..., :d_axis], row), rot(xf[..., d_axis:], col)], axis=-1)
    return out.astype(x.dtype)


def gla_scan(q, k, v, g, s0):
    bsz, L, H, _ = q.shape
    dv = v.shape[-1]
    n = L // GLA_CHUNK

    def chunks(t):
        return t.astype(F32).reshape(bsz, n, GLA_CHUNK, H, t.shape[-1]).transpose(1, 0, 3, 2, 4)

    lower = jnp.tril(jnp.ones((GLA_CHUNK, GLA_CHUNK), dtype=bool))[:, :, None]

    def body(s, inp):
        qc, kc, vc, gc = inp
        b = jnp.cumsum(gc, axis=-2)
        o = jnp.einsum('bhtd,bhdv->bhtv', qc * jnp.exp(b), s)
        w = jnp.exp(jnp.where(lower, b[..., :, None, :] - b[..., None, :, :], -jnp.inf))
        att = jnp.einsum('bhtd,bhsd,bhtsd->bhts', qc, kc, w)
        o = o + jnp.einsum('bhts,bhsv->bhtv', att, vc)
        b_last = b[..., -1:, :]
        s = jnp.exp(b_last)[..., 0, :, None] * s + jnp.einsum('bhsd,bhsv->bhdv', kc * jnp.exp(b_last - b), vc)
        return s, o

    s_fin, o = lax.scan(body, s0.astype(F32), (chunks(q), chunks(k), chunks(v), chunks(g)))
    o = o.transpose(1, 0, 3, 2, 4).reshape(bsz, L, H, dv)
    return o, s_fin


def gla_bidir(q, k, v, g_f, g_b, s0_f, s0_b):
    o_f, s_f = gla_scan(q, k, v, g_f, s0_f)
    fl = lambda t: jnp.flip(t, axis=1)
    o_b, s_b = gla_scan(fl(q), fl(k), fl(v), fl(g_b), s0_b)
    return o_f + fl(o_b), s_f, s_b


def linear_scan(a, b, h0):
    def combine(e1, e2):
        a1, b1 = e1
        a2, b2 = e2
        return a1 * a2, a2 * b1 + b2
    a_acc, b_acc = lax.associative_scan(combine, (a, b), axis=1)
    return b_acc + a_acc * h0[:, None, :]


def rglru_dir(xc, w_a, b_a, w_x, b_x, lam, h0):
    bsz, L, W = xc.shape
    xb = xc.reshape(bsz, L, LRU_BLOCKS, LRU_BW)
    r = jax.nn.sigmoid(jnp.einsum('blgi,gij->blgj', xb, w_a.astype(F32)).reshape(bsz, L, W) + b_a.astype(F32))
    i = jax.nn.sigmoid(jnp.einsum('blgi,gij->blgj', xb, w_x.astype(F32)).reshape(bsz, L, W) + b_x.astype(F32))
    log_a = LRU_C * r * jax.nn.log_sigmoid(lam.astype(F32))
    a = jnp.exp(log_a)
    u = jnp.sqrt(-jnp.expm1(2 * log_a)) * (i * xc)
    return linear_scan(a, u, h0)


def dwconv_centred(x, w, b):
    L = x.shape[1]
    left = LRU_CONV_W // 2
    right = LRU_CONV_W - 1 - left
    xp = jnp.pad(x, ((0, 0), (left, right), (0, 0)))
    out = b + xp[:, 0:L] * w[0]
    for j in range(1, LRU_CONV_W):
        out = out + xp[:, j:j + L] * w[j]
    return out


def even_mixer(h_lat, h_ctx, w_in, w_out, gate_up, gate_b, gla_g, conv_w, conv_b,
               w_a, b_a, w_x, b_x, lam, need_ctx):
    sizes = [GLA_KEY_W, GLA_KEY_W, GLA_VAL_W, GLA_VAL_W, 2 * GLA_GATE_RANK, LRU_W, LRU_W]
    splits = np.cumsum(sizes)[:-1].tolist()

    def prep(h, use_rope):
        bsz, L, _ = h.shape
        q, k, v, o_gate, g_low, x_r, y_r = jnp.split(h @ w_in, splits, axis=-1)
        q = q.reshape(bsz, L, GLA_HEADS, GLA_DK) * GLA_DK ** -0.5
        k = k.reshape(bsz, L, GLA_HEADS, GLA_DK)
        if use_rope:
            q, k = axial_rope(q), axial_rope(k)
        v = v.reshape(bsz, L, GLA_HEADS, GLA_DV)
        g_low = g_low.reshape(bsz, L, 2, GLA_GATE_RANK)
        z = (jnp.einsum('blnr,nrk->blnk', g_low, gate_up) + gate_b).astype(F32)
        g = (jax.nn.log_sigmoid(z) / GLA_GATE_TAU).reshape(bsz, L, 2, GLA_HEADS, GLA_DK)
        xc = dwconv_centred(x_r, conv_w, conv_b).astype(F32)
        return q, k, v, g[:, :, 0], g[:, :, 1], o_gate, xc, y_r

    def lru_both(xc, h0f, h0b):
        hf = rglru_dir(xc, w_a[0], b_a[0], w_x[0], b_x[0], lam[0], h0f)
        hb = jnp.flip(rglru_dir(jnp.flip(xc, axis=1), w_a[1], b_a[1], w_x[1], b_x[1], lam[1], h0b), axis=1)
        return hf, hb

    def merge(h, o, o_gate, hf, hb, y_r):
        bsz, L = o.shape[:2]
        a_out = rms_norm(o, gla_g.reshape(GLA_HEADS, GLA_DV)).reshape(bsz, L, GLA_VAL_W) * jax.nn.silu(o_gate)
        b_out = (hf + hb) * jax.nn.gelu(y_r)
        return (jnp.concatenate([a_out, b_out], axis=-1) @ w_out).astype(h.dtype)

    bsz = h_lat.shape[0]
    qc, kc, vc, gfc, gbc, ogc, xcc, ycc = prep(h_ctx, False)
    ql, kl, vl, gfl, gbl, ogl, xcl, ycl = prep(h_lat, True)
    zero_s = jnp.zeros((bsz, GLA_HEADS, GLA_DK, GLA_DV), F32)
    o_ctx, s_f, s_b = gla_bidir(qc, kc, vc, gfc, gbc, zero_s, zero_s)
    o_lat, _, _ = gla_bidir(ql, kl, vl, gfl, gbl, s_f, s_b)
    zero_h = jnp.zeros((bsz, LRU_W), F32)
    hf_c, hb_c = lru_both(xcc, zero_h, zero_h)
    hf_l, hb_l = lru_both(xcl, hf_c[:, -1], hb_c[:, 0])
    y_lat = merge(h_lat, o_lat, ogl, hf_l, hb_l, ycl)
    y_ctx = merge(h_ctx, o_ctx, ogc, hf_c, hb_c, ycc) if need_ctx else None
    return y_lat, y_ctx


def na_mixer(h_lat, h_ctx, w_qkv, w_out, rel_bias, need_ctx):
    bsz, L, _ = h_lat.shape
    rows = L // GRID_W
    win_r = min(NA_WIN_ROWS, rows)
    n_ctx = h_ctx.shape[1]

    def heads(t, n):
        return t.reshape(bsz, n, NA_HEADS, NA_HD).transpose(0, 2, 1, 3)

    q_l, k_l, v_l = jnp.split(h_lat @ w_qkv, 3, axis=-1)
    q_l = heads(q_l, L) * NA_HD ** -0.5
    k_l, v_l = heads(k_l, L), heads(v_l, L)
    k_c, v_c = jnp.split(h_ctx @ w_qkv[:, D_MODEL:], 2, axis=-1)
    k_c, v_c = heads(k_c, n_ctx), heads(v_c, n_ctx)

    grid = lambda t: t.reshape(bsz, NA_HEADS, rows, GRID_W, NA_HD)
    qg, kg, vg = grid(q_l), grid(k_l), grid(v_l)

    col = jnp.arange(GRID_W)
    col_start = jnp.clip(col - NA_WIN_COLS // 2, 0, GRID_W - NA_WIN_COLS)
    col_mask = (col[None, :] >= col_start[:, None]) & (col[None, :] < col_start[:, None] + NA_WIN_COLS)
    dc_idx = jnp.clip(col[None, :] - col[:, None] + NA_WIN_COLS - 1, 0, 2 * NA_WIN_COLS - 2)
    bias_cols = rel_bias.astype(F32)[:, :, dc_idx]
    mask = jnp.tile(col_mask, (1, win_r))
    n_band = win_r * GRID_W

    def row_block(r):
        rs = jnp.clip(r - win_r // 2, 0, rows - win_r)
        k_band = lax.dynamic_slice_in_dim(kg, rs, win_r, axis=2).reshape(bsz, NA_HEADS, n_band, NA_HD)
        v_band = lax.dynamic_slice_in_dim(vg, rs, win_r, axis=2).reshape(bsz, NA_HEADS, n_band, NA_HD)
        q_row = lax.dynamic_index_in_dim(qg, r, axis=2, keepdims=False)
        dr_idx = rs + jnp.arange(win_r) - r + NA_WIN_ROWS - 1
        bias = jnp.take(bias_cols, dr_idx, axis=1).transpose(0, 2, 1, 3).reshape(NA_HEADS, GRID_W, n_band)
        s_lat = jnp.einsum('bhqd,bhkd->bhqk', q_row, k_band).astype(F32) + bias
        s_lat = jnp.where(mask, s_lat, -jnp.inf)
        s_ctx = jnp.einsum('bhqd,bhkd->bhqk', q_row, k_c).astype(F32)
        p = jax.nn.softmax(jnp.concatenate([s_lat, s_ctx], axis=-1), axis=-1).astype(v_band.dtype)
        return (jnp.einsum('bhqk,bhkd->bhqd', p[..., :n_band], v_band)
                + jnp.einsum('bhqk,bhkd->bhqd', p[..., n_band:], v_c))

    o = lax.map(row_block, jnp.arange(rows))
    o = o.transpose(1, 0, 3, 2, 4).reshape(bsz, L, D_MODEL)
    y_lat = o @ w_out
    y_ctx = None
    if need_ctx:
        q_c = heads(h_ctx @ w_qkv[:, :D_MODEL], n_ctx) * NA_HD ** -0.5
        p_c = jax.nn.softmax(jnp.einsum('bhqd,bhkd->bhqk', q_c, k_c).astype(F32), axis=-1).astype(v_c.dtype)
        o_c = jnp.einsum('bhqk,bhkd->bhqd', p_c, v_c).transpose(0, 2, 1, 3).reshape(bsz, n_ctx, D_MODEL)
        y_ctx = o_c @ w_out
    return y_lat, y_ctx


def sq_relu_mlp(h, w_up, w_down):
    return jnp.square(jax.nn.relu(h @ w_up)) @ w_down


def setup_inputs(seed: int = 0) -> dict:
    key = jax.random.key(seed)
    ks = iter(jax.random.split(key, 40))
    D = D_MODEL

    def nrm(shape, scale):
        return jax.random.normal(next(ks), shape, F32) * scale

    lam_u = jax.random.uniform(next(ks), (N_EVEN, 2, LRU_W), F32, minval=0.9, maxval=0.999)
    root = lam_u ** (1.0 / LRU_C)
    lru_lambda = jnp.log(root) - jnp.log1p(-root)
    return {
        "x": nrm((BATCH, SEQ, D), 1.0),
        "c": nrm((BATCH, D), 1.0),
        "ctx": nrm((BATCH, CTX_LEN, D), 1.0),
        "c_ctx": nrm((D,), 1.0),
        "mod_w": nrm((DEPTH, D, N_MOD * D), 0.5 * D ** -0.5),
        "mod_b": nrm((DEPTH, N_MOD * D), 0.01),
        "norm1_g": 1.0 + nrm((DEPTH, D), 0.02),
        "norm2_g": 1.0 + nrm((DEPTH, D), 0.02),
        "mlp_w_up": nrm((DEPTH, D, D_FF), D ** -0.5),
        "mlp_w_down": nrm((DEPTH, D_FF, D), D_FF ** -0.5),
        "ev_w_in": nrm((N_EVEN, D, IN_EVEN), D ** -0.5),
        "ev_w_out": nrm((N_EVEN, MIX_W, D), MIX_W ** -0.5),
        "gla_gate_up": nrm((N_EVEN, 2, GLA_GATE_RANK, GLA_KEY_W), GLA_GATE_RANK ** -0.5),
        "gla_gate_b": nrm((N_EVEN, 2, GLA_KEY_W), 0.1),
        "gla_norm_g": 1.0 + nrm((N_EVEN, GLA_VAL_W), 0.02),
        "lru_conv_w": nrm((N_EVEN, LRU_CONV_W, LRU_W), LRU_CONV_W ** -0.5),
        "lru_conv_b": nrm((N_EVEN, LRU_W), 0.01),
        "lru_w_a": nrm((N_EVEN, 2, LRU_BLOCKS, LRU_BW, LRU_BW), LRU_BW ** -0.5),
        "lru_b_a": nrm((N_EVEN, 2, LRU_W), 0.01),
        "lru_w_x": nrm((N_EVEN, 2, LRU_BLOCKS, LRU_BW, LRU_BW), LRU_BW ** -0.5),
        "lru_b_x": nrm((N_EVEN, 2, LRU_W), 0.01),
        "lru_lambda": lru_lambda,
        "na_w_qkv": nrm((N_ODD, D, 3 * D), D ** -0.5),
        "na_w_out": nrm((N_ODD, D, D), D ** -0.5),
        "na_rel_bias": nrm((N_ODD, NA_HEADS, 2 * NA_WIN_ROWS - 1, 2 * NA_WIN_COLS - 1), 0.02),
        "final_norm_g": 1.0 + nrm((D,), 0.02),
    }


def reference(x, c, ctx, c_ctx, mod_w, mod_b, norm1_g, norm2_g, mlp_w_up, mlp_w_down,
              ev_w_in, ev_w_out, gla_gate_up, gla_gate_b, gla_norm_g, lru_conv_w, lru_conv_b,
              lru_w_a, lru_b_a, lru_w_x, lru_b_x, lru_lambda, na_w_qkv, na_w_out, na_rel_bias,
              final_norm_g):
    silu_c = jax.nn.silu(c)
    silu_cc = jax.nn.silu(c_ctx)
    for layer in range(DEPTH):
        need_ctx = layer < DEPTH - 1
        mod_l = (silu_c @ mod_w[layer] + mod_b[layer])[:, None, :]
        mod_c = silu_cc @ mod_w[layer] + mod_b[layer]
        sh1, sc1, g1, sh2, sc2, g2 = jnp.split(mod_l, N_MOD, axis=-1)
        csh1, csc1, cg1, csh2, csc2, cg2 = jnp.split(mod_c, N_MOD, axis=-1)
        h_lat = modulate(x, norm1_g[layer], sh1, sc1)
        h_ctx = modulate(ctx, norm1_g[layer], csh1, csc1)
        if layer % 2 == 0:
            i = layer // 2
            y_lat, y_ctx = even_mixer(h_lat, h_ctx, ev_w_in[i], ev_w_out[i], gla_gate_up[i], gla_gate_b[i],
                                      gla_norm_g[i], lru_conv_w[i], lru_conv_b[i], lru_w_a[i], lru_b_a[i],
                                      lru_w_x[i], lru_b_x[i], lru_lambda[i], need_ctx)
        else:
            i = layer // 2
            y_lat, y_ctx = na_mixer(h_lat, h_ctx, na_w_qkv[i], na_w_out[i], na_rel_bias[i], need_ctx)
        x = x + g1 * y_lat
        x = x + g2 * sq_relu_mlp(modulate(x, norm2_g[layer], sh2, sc2), mlp_w_up[layer], mlp_w_down[layer])
        if need_ctx:
            ctx = ctx + cg1 * y_ctx
            ctx = ctx + cg2 * sq_relu_mlp(modulate(ctx, norm2_g[layer], csh2, csc2), mlp_w_up[layer], mlp_w_down[layer])
    return rms_norm(x, final_norm_g)
```

```cpp
#include <hip/hip_runtime.h>
#include <hip/hip_cooperative_groups.h>
#include <cstdio>
#include <cstdint>
namespace cg = cooperative_groups;

#define LAS __attribute__((address_space(3)))
typedef unsigned short bf16_t;
typedef short bf16x8 __attribute__((ext_vector_type(8)));
typedef float f32x4 __attribute__((ext_vector_type(4)));
typedef float f32x2 __attribute__((ext_vector_type(2)));
typedef unsigned u32x4 __attribute__((ext_vector_type(4)));
typedef unsigned u32x2 __attribute__((ext_vector_type(2)));

constexpr int D = 2048, NB = 4, SEQ = 4096, CTX = 256, DFF = 8192;
constexpr int MLAT = NB * SEQ, MCTX = NB * CTX, MALL = MLAT + MCTX;
constexpr int NIN = 4352;
constexpr int C_Q = 0, C_K = 512, C_OG = 1024, C_XR = 2048, C_YR = 3072, C_GL = 4096;
constexpr int NQKV = 6144, NQK = 4096;
constexpr float EPS = 1e-6f;

constexpr size_t MiB = 1u << 20;
constexpr size_t WS_MODV = 0;
constexpr size_t WS_BAR = 544 * 1024;
constexpr size_t WS_ROPE = 512 * 1024;
constexpr size_t WS_WIN = 1 * MiB;
constexpr size_t WS_WV0 = 18 * MiB;
constexpr size_t WS_WOUT = 22 * MiB;
constexpr size_t WS_WUP = 30 * MiB;
constexpr size_t WS_WDN = 94 * MiB;
constexpr size_t WS_WQKV = 158 * MiB;
constexpr size_t WS_WNO = 182 * MiB;
constexpr size_t WS_XC = 190 * MiB;
constexpr size_t WS_A = 198 * MiB;
constexpr size_t WS_R = 266 * MiB;
constexpr size_t WS_P = WS_R;
constexpr size_t WS_VT = WS_R + 146 * MiB;
constexpr size_t WS_OF = WS_R + 214 * MiB;
constexpr size_t WS_OB = WS_R + 282 * MiB;
constexpr size_t WS_HF = WS_R + 350 * MiB;
constexpr size_t WS_HB = WS_R + 384 * MiB;
constexpr size_t WS_GQ = WS_A, WS_GK = WS_A + 34 * MiB;
constexpr size_t WS_GATT = WS_R + 418 * MiB, WS_GBLE = WS_R + 435 * MiB;
constexpr size_t WS_PART = WS_R + 300 * MiB;
constexpr size_t WS_H = WS_R;
constexpr size_t WS_LRUW = WS_R + 437 * MiB;
constexpr size_t WS_END = WS_R + 439 * MiB;

constexpr int LDS_BYTES = 147456;

struct Params {
    const float *x, *c, *ctx, *c_ctx, *mod_w, *mod_b, *norm1_g, *norm2_g, *mlp_up, *mlp_down, *ev_w_in, *ev_w_out;
    const float *gate_up, *gate_b, *gla_g, *conv_w, *conv_b, *w_a, *b_a, *w_x, *b_x, *lam, *na_qkv, *na_out, *rel_bias, *fin_g;
    float* out; unsigned char* ws;
    int ph_lo, ph_hi;
};

typedef __bf16 hwbf16x2 __attribute__((ext_vector_type(2)));
__device__ __forceinline__ unsigned f2bf(float f) { return (unsigned)__builtin_bit_cast(unsigned short, (__bf16)f); }
__device__ __forceinline__ unsigned pk2(float lo, float hi) { return __builtin_bit_cast(unsigned, __builtin_convertvector((f32x2){lo, hi}, hwbf16x2)); }
__device__ __forceinline__ float bflo(unsigned w) { return __builtin_bit_cast(float, w << 16); }
__device__ __forceinline__ float bfhi(unsigned w) { return __builtin_bit_cast(float, w & 0xffff0000u); }
__device__ __forceinline__ float bf1(bf16_t v) { return __builtin_bit_cast(float, (unsigned)v << 16); }
__device__ __forceinline__ float wave_sum(float v) {
#pragma unroll
    for (int o = 1; o < 64; o <<= 1) v += __shfl_xor(v, o);
    return v;
}
__device__ __forceinline__ float dpp_ror(float v, const int ctrl) { return v; }
#define ROW_ROR(v, n) __builtin_bit_cast(float, __builtin_amdgcn_update_dpp(0, __builtin_bit_cast(int, (v)), 0x120 + (n), 0xf, 0xf, false))
__device__ __forceinline__ float row16_max(float v) { v = fmaxf(v, ROW_ROR(v, 8)); v = fmaxf(v, ROW_ROR(v, 4)); v = fmaxf(v, ROW_ROR(v, 2)); v = fmaxf(v, ROW_ROR(v, 1)); return v; }
__device__ __forceinline__ float row16_sum(float v) { v += ROW_ROR(v, 8); v += ROW_ROR(v, 4); v += ROW_ROR(v, 2); v += ROW_ROR(v, 1); return v; }
__device__ __forceinline__ float sigmoidf_(float x) { return 1.f / (1.f + __expf(-x)); }
__device__ __forceinline__ float logsigf_(float z) { return fminf(z, 0.f) - __logf(1.f + __expf(-fabsf(z))); }
__device__ __forceinline__ float siluf_(float x) { return x / (1.f + __expf(-x)); }
__device__ __forceinline__ float gelu_tanh(float x) {
    const float u = 0.7978845608028654f * (x + 0.044715f * x * x * x);
    const float t = 1.f - 2.f / (1.f + __expf(2.f * u));
    return 0.5f * x * (1.f + t);
}
__device__ __forceinline__ void unpack8(u32x4 w, float* f) {
    f[0] = bflo(w.x); f[1] = bfhi(w.x); f[2] = bflo(w.y); f[3] = bfhi(w.y); f[4] = bflo(w.z); f[5] = bfhi(w.z); f[6] = bflo(w.w); f[7] = bfhi(w.w);
}
__device__ __forceinline__ bf16x8 as_bf16x8(u32x4 w) { return __builtin_bit_cast(bf16x8, w); }

namespace pg8 {
constexpr int BM = 256, BK = 64, HALF = 128, HTB = HALF * BK * 2, STAGE_BYTES = 8 * HTB, NXCD = 8, WGM = 4;
__host__ __device__ __forceinline__ int lds_byte(int r, int c) { const int st = (r >> 4) * 2 + (c >> 5), rr = r & 15, cc = c & 31, ob = rr * 64 + cc * 2; return st * 1024 + (ob ^ (((ob >> 9) & 1) << 5)); }
__host__ __device__ __forceinline__ void stage_rc(int b, int& R, int& C) { const int st = b / 1024, sb = b % 1024, swz = sb ^ (((sb >> 9) & 1) << 5); R = (st >> 1) * 16 + swz / 64; C = (st & 1) * 32 + (swz % 64) / 2; }
__host__ __device__ __forceinline__ int perm32(int rho) { const int n = rho >> 4, i = rho & 15; return 8 * (i >> 2) + 4 * n + (i & 3); }
struct Unit { const char* a; const char* b; int nt, pm, pn, mode, ksi; };
struct Gemm { int ld; };
struct Seg { const char* a; const char* b; int nM, nN, ks, nt, mode, count; };
struct SegOrder {
    Seg s0, s1; int nseg, G, c; size_t tstep;
    __device__ __forceinline__ void init(int ld, int G_, int c_) { G = G_; c = c_; tstep = (size_t)BM * ld * 2; nseg = 0; s1.count = 0; }
    __device__ __forceinline__ void add(const void* a, const void* b, int nM, int nN, int ks, int nt, int mode) {
        Seg q; q.a = (const char*)a; q.b = (const char*)b; q.nM = nM; q.nN = nN; q.ks = ks; q.nt = nt; q.mode = mode; q.count = nM * nN * ks;
        if (nseg == 0) s0 = q; else s1 = q; ++nseg; }
    __device__ __forceinline__ bool next(int i, Unit& u) const {
        long L = (long)i * G + c; bool second = false;
        if (L >= s0.count) { L -= s0.count; second = true; if (L >= s1.count) return false; }
        const char* qa = second ? s1.a : s0.a; const char* qb = second ? s1.b : s0.b;
        const int nM = second ? s1.nM : s0.nM, nN = second ? s1.nN : s0.nN, ks = second ? s1.ks : s0.ks, qnt = second ? s1.nt : s0.nt, mode = second ? s1.mode : s0.mode;
        const int ksi = (int)(L % ks); int wgid = (int)(L / ks); const int nwg = nM * nN;
        { const int qq = nwg / NXCD, r = nwg % NXCD, xcd = wgid % NXCD, off = wgid / NXCD; wgid = (xcd < r ? xcd * (qq + 1) : r * (qq + 1) + (xcd - r) * qq) + off; }
        const int nig = WGM * nN, gid = wgid / nig, fm = gid * WGM, gsz = (nM - fm) < WGM ? (nM - fm) : WGM;
        u.pm = fm + ((wgid % nig) % gsz); u.pn = (wgid % nig) / gsz; u.nt = qnt; u.mode = mode; u.ksi = ksi;
        const size_t koff = (size_t)ksi * qnt * (BK * 2);
        u.a = qa + (size_t)u.pm * tstep + koff; u.b = qb + (size_t)u.pn * tstep + koff; return true;
    }
    __device__ __forceinline__ void a_ready(const Unit&) const {}
    __device__ __forceinline__ void done(const Unit&) const {}
};
__device__ __forceinline__ unsigned cvt_pk_bf16(float lo, float hi) { return pk2(lo, hi); }

struct EpiBf16 {
    static constexpr bool PERM = true, AFTER_DRAIN = false;
    bf16_t* O0; int ldc0; bf16_t* O1; int ldc1; int ACT;
    __device__ __forceinline__ void operator()(const f32x4 (&acc)[2][2][4][2], const Unit& u, int wr, int wc, int fr, int fq) const {
        const int row0 = u.pm * BM + wr * 64 + fr; const int col0 = u.pn * BM + wc * 32 + 8 * fq;
        bf16_t* O = u.mode ? O1 : O0; const int ldc = u.mode ? ldc1 : ldc0;
#pragma unroll
        for (int ai = 0; ai < 2; ++ai)
#pragma unroll
            for (int m = 0; m < 4; ++m) { bf16_t* rowp = O + (size_t)(row0 + ai * HALF + m * 16) * ldc + col0;
#pragma unroll
                for (int bj = 0; bj < 2; ++bj) { f32x4 v0 = acc[ai][bj][m][0], v1 = acc[ai][bj][m][1];
                    if (ACT == 1) {
#pragma unroll
                        for (int e = 0; e < 4; ++e) { float a = fmaxf(v0[e], 0.f), b = fmaxf(v1[e], 0.f); v0[e] = a * a; v1[e] = b * b; } }
                    u32x4 w; w.x = cvt_pk_bf16(v0[0], v0[1]); w.y = cvt_pk_bf16(v0[2], v0[3]); w.z = cvt_pk_bf16(v1[0], v1[1]); w.w = cvt_pk_bf16(v1[2], v1[3]);
                    *(u32x4*)(rowp + bj * HALF) = w; } }
    }
};
struct EpiResid {
    static constexpr bool PERM = false, AFTER_DRAIN = false;
    const float* base_lat; float* out_lat; float* out_ctx; const float* gate;
    __device__ __forceinline__ void operator()(const f32x4 (&acc)[2][2][4][2], const Unit& u, int wr, int wc, int fr, int fq) const {
        const bool isl = u.mode == 0;
        const int bidx = isl ? (u.pm >> 4) : 4;
        const float* gp = gate + (size_t)bidx * (6 * D) + u.pn * BM + wc * 32 + 4 * fq;
        const size_t eoff = ((size_t)u.pm * BM + wr * 64 + fr) * D + u.pn * BM + wc * 32 + 4 * fq;
        f32x4 gv[2][2];
#pragma unroll
        for (int bj = 0; bj < 2; ++bj)
#pragma unroll
            for (int n = 0; n < 2; ++n) gv[bj][n] = *(const f32x4*)(gp + bj * HALF + n * 16);
        if (isl) {
            const float* bp = base_lat + eoff; float* op = out_lat + eoff;
#pragma unroll
            for (int ai = 0; ai < 2; ++ai) {
                f32x4 bs[4][2][2];
#pragma unroll
                for (int m = 0; m < 4; ++m)
#pragma unroll
                    for (int bj = 0; bj < 2; ++bj)
#pragma unroll
                        for (int n = 0; n < 2; ++n) bs[m][bj][n] = *(const f32x4*)(bp + (size_t)(ai * HALF + m * 16) * D + bj * HALF + n * 16);
                asm volatile("" ::: "memory");
#pragma unroll
                for (int m = 0; m < 4; ++m)
#pragma unroll
                    for (int bj = 0; bj < 2; ++bj)
#pragma unroll
                        for (int n = 0; n < 2; ++n) *(f32x4*)(op + (size_t)(ai * HALF + m * 16) * D + bj * HALF + n * 16) = bs[m][bj][n] + gv[bj][n] * acc[ai][bj][m][n];
                asm volatile("" ::: "memory");
            }
        } else {
            float* op = out_ctx + (size_t)u.ksi * MCTX * D + eoff;
#pragma unroll
            for (int ai = 0; ai < 2; ++ai)
#pragma unroll
                for (int m = 0; m < 4; ++m) { const size_t off = (size_t)(ai * HALF + m * 16) * D;
#pragma unroll
                    for (int bj = 0; bj < 2; ++bj)
#pragma unroll
                        for (int n = 0; n < 2; ++n) *(f32x4*)(op + off + bj * HALF + n * 16) = acc[ai][bj][m][n]; }
        }
    }
};

template <class Epi, class Sched, bool ALIGN_EPI = false, bool SP2 = false>
__device__ __forceinline__ void gemm_phase(LAS unsigned char* lds, const Gemm g, const Sched& S, const Epi& E) {
    const int tid = threadIdx.x, wid = __builtin_amdgcn_readfirstlane(tid >> 6), lane = tid & 63, wr = wid >> 2, wc = wid & 3, fr = lane & 15, fq = lane >> 4;
    const int K = g.ld;
    unsigned voffA[2], voffB[2];
#pragma unroll
    for (int i = 0; i < 2; ++i) { int R, C; stage_rc(tid * 16 + i * 8192, R, C); const int Rb = Epi::PERM ? ((R & ~31) + perm32(R & 31)) : R;
        voffA[i] = (unsigned)(R * K + C) * 2u; voffB[i] = (unsigned)(Rb * K + C) * 2u; }
    const size_t kstep = (size_t)(BK * 2);
    const size_t hstep = (size_t)HALF * K * 2;
    const unsigned ldsw = (unsigned)wid * 1024u;
    const int aoff = lds_byte(wr * 64 + fr, fq * 8), boff = lds_byte(wc * 32 + fr, fq * 8);
#define PG8_SA(b, h) (((b) * 2 + (h)) * HTB)
#define PG8_SB(b, h) ((4 + (b) * 2 + (h)) * HTB)
#define PG8_STAGE(bufoff, gbase, voff) do { _Pragma("unroll") for (int _i = 0; _i < 2; ++_i) \
        __builtin_amdgcn_global_load_lds((const unsigned*)((const char*)(gbase) + (voff)[_i]), (LAS unsigned*)(lds + (bufoff) + ldsw + _i * 8192), 16, 0, 0); } while (0)
#define PG8_LDA(dst, b, h) do { _Pragma("unroll") for (int m = 0; m < 4; ++m) _Pragma("unroll") for (int k = 0; k < 2; ++k) dst[m][k] = *(const LAS bf16x8*)(lds + PG8_SA(b, h) + aoff + m * 2048 + k * 1024); } while (0)
#define PG8_LDB(dst, b, h) do { _Pragma("unroll") for (int n = 0; n < 2; ++n) _Pragma("unroll") for (int k = 0; k < 2; ++k) dst[n][k] = *(const LAS bf16x8*)(lds + PG8_SB(b, h) + boff + n * 2048 + k * 1024); } while (0)
#define PG8_MMA(ai, bj, At, Bt) do { __builtin_amdgcn_s_setprio(1); _Pragma("unroll") for (int m = 0; m < 4; ++m) _Pragma("unroll") for (int n = 0; n < 2; ++n) _Pragma("unroll") for (int k = 0; k < 2; ++k) \
        acc[ai][bj][m][n] = __builtin_amdgcn_mfma_f32_16x16x32_bf16(Bt[n][k], At[m][k], acc[ai][bj][m][n], 0, 0, 0); __builtin_amdgcn_s_setprio(0); } while (0)
#define PG8_WAIT_V(n) asm volatile("s_waitcnt vmcnt(" #n ")" ::: "memory")
#define PG8_WAIT_L(n) asm volatile("s_waitcnt lgkmcnt(" #n ")" ::: "memory")
#define PG8_BAR __builtin_amdgcn_s_barrier()
#define PG8_SCHED __builtin_amdgcn_sched_barrier(0)
    Unit cur, nxt; int ui = 0;
    if (!S.next(0, cur)) return;
    f32x4 acc[2][2][4][2];
#pragma unroll
    for (int a = 0; a < 2; ++a)
#pragma unroll
        for (int b = 0; b < 2; ++b)
#pragma unroll
            for (int m = 0; m < 4; ++m)
#pragma unroll
                for (int n = 0; n < 2; ++n) acc[a][b][m][n] = (f32x4){0.f, 0.f, 0.f, 0.f};
    bf16x8 At[4][2], B0[2][2], B1[2][2];
    const char* cA = cur.a; const char* cB = cur.b;
    S.a_ready(cur);
    if constexpr (SP2) {
        PG8_STAGE(PG8_SB(0, 0), cB, voffB); PG8_STAGE(PG8_SB(0, 1), cB + hstep, voffB); PG8_STAGE(PG8_SA(0, 0), cA, voffA); PG8_STAGE(PG8_SA(0, 1), cA + hstep, voffA);
        if (wr == 1) PG8_BAR;
        PG8_WAIT_V(2); PG8_BAR;
        PG8_STAGE(PG8_SB(1, 0), cB + kstep, voffB); PG8_STAGE(PG8_SA(1, 0), cA + kstep, voffA); PG8_STAGE(PG8_SB(1, 1), cB + hstep + kstep, voffB);
        PG8_WAIT_V(6); PG8_BAR;
    } else {
        PG8_STAGE(PG8_SB(0, 0), cB, voffB); PG8_STAGE(PG8_SA(0, 0), cA, voffA); PG8_STAGE(PG8_SB(0, 1), cB + hstep, voffB); PG8_STAGE(PG8_SA(0, 1), cA + hstep, voffA);
        if (wr == 1) PG8_BAR;
        PG8_WAIT_V(4); PG8_BAR;
        PG8_STAGE(PG8_SB(1, 0), cB + kstep, voffB); PG8_STAGE(PG8_SA(1, 0), cA + kstep, voffA); PG8_STAGE(PG8_SB(1, 1), cB + hstep + kstep, voffB);
        PG8_WAIT_V(6); PG8_BAR;
    }
    for (;;) {
        const bool has_next = S.next(ui + 1, nxt);
        const char* nA = has_next ? nxt.a : cA; const char* nB = has_next ? nxt.b : cB;
        const int nt = cur.nt;
        for (int t = 0; t < nt; t += 2) {
            const bool last = (t == nt - 2);
            const char* a1 = cA + (size_t)(t + 1) * kstep;
            const char* a2 = last ? nA : cA + (size_t)(t + 2) * kstep; const char* b2 = last ? nB : cB + (size_t)(t + 2) * kstep;
            const char* a3 = a2 + kstep; const char* b3 = b2 + kstep;
            if (last && has_next) S.a_ready(nxt);
            if constexpr (SP2) {
            PG8_LDB(B0, 0, 0); PG8_LDB(B1, 0, 1); PG8_SCHED; PG8_LDA(At, 0, 0); PG8_STAGE(PG8_SA(1, 1), a1 + hstep, voffA);
            PG8_WAIT_V(8); PG8_WAIT_L(0); PG8_BAR; PG8_MMA(0, 0, At, B0); PG8_MMA(0, 1, At, B1); PG8_BAR; PG8_SCHED;
            PG8_LDA(At, 0, 1); PG8_STAGE(PG8_SB(0, 0), b2, voffB); PG8_STAGE(PG8_SB(0, 1), b2 + hstep, voffB); PG8_STAGE(PG8_SA(0, 0), a2, voffA);
            PG8_WAIT_V(8); PG8_WAIT_L(0); PG8_BAR; PG8_MMA(1, 0, At, B0); PG8_MMA(1, 1, At, B1); PG8_BAR; PG8_SCHED;
            PG8_LDB(B0, 1, 0); PG8_LDB(B1, 1, 1); PG8_SCHED; PG8_LDA(At, 1, 0); PG8_STAGE(PG8_SA(0, 1), a2 + hstep, voffA);
            PG8_WAIT_V(8); PG8_WAIT_L(0); PG8_BAR; PG8_MMA(0, 0, At, B0); PG8_MMA(0, 1, At, B1); PG8_BAR; PG8_SCHED;
            PG8_LDA(At, 1, 1); PG8_STAGE(PG8_SB(1, 0), b3, voffB); PG8_STAGE(PG8_SB(1, 1), b3 + hstep, voffB); PG8_STAGE(PG8_SA(1, 0), a3, voffA);
            PG8_WAIT_V(8); PG8_WAIT_L(0); PG8_BAR; PG8_MMA(1, 0, At, B0); PG8_MMA(1, 1, At, B1); PG8_BAR; PG8_SCHED;
            } else {
            PG8_LDB(B0, 0, 0); PG8_SCHED; PG8_LDA(At, 0, 0); PG8_STAGE(PG8_SA(1, 1), a1 + hstep, voffA);
            PG8_WAIT_L(8); PG8_BAR; PG8_WAIT_L(0); PG8_MMA(0, 0, At, B0); PG8_BAR; PG8_SCHED;
            PG8_LDB(B1, 0, 1); PG8_STAGE(PG8_SB(0, 0), b2, voffB);
            PG8_BAR; PG8_WAIT_L(0); PG8_MMA(0, 1, At, B1); PG8_BAR;
            PG8_LDA(At, 0, 1); PG8_STAGE(PG8_SA(0, 0), a2, voffA);
            PG8_BAR; PG8_WAIT_L(0); PG8_MMA(1, 0, At, B0); PG8_BAR; PG8_SCHED;
            PG8_STAGE(PG8_SB(0, 1), b2 + hstep, voffB);
            PG8_WAIT_V(6); PG8_BAR; PG8_MMA(1, 1, At, B1); PG8_BAR;
            PG8_LDB(B0, 1, 0); PG8_SCHED; PG8_LDA(At, 1, 0); PG8_STAGE(PG8_SA(0, 1), a2 + hstep, voffA);
            PG8_WAIT_L(8); PG8_BAR; PG8_WAIT_L(0); PG8_MMA(0, 0, At, B0); PG8_BAR; PG8_SCHED;
            PG8_LDB(B1, 1, 1); PG8_STAGE(PG8_SB(1, 0), b3, voffB);
            PG8_BAR; PG8_WAIT_L(0); PG8_MMA(0, 1, At, B1); PG8_BAR;
            PG8_LDA(At, 1, 1); PG8_STAGE(PG8_SA(1, 0), a3, voffA);
            PG8_BAR; PG8_WAIT_L(0); PG8_MMA(1, 0, At, B0); PG8_BAR; PG8_SCHED;
            PG8_STAGE(PG8_SB(1, 1), b3 + hstep, voffB);
            PG8_WAIT_V(6); PG8_BAR; PG8_MMA(1, 1, At, B1); PG8_BAR;
            }
        }
        if constexpr (ALIGN_EPI) { if (wr == 0) PG8_BAR; }
        if constexpr (!Epi::AFTER_DRAIN) { E(acc, cur, wr, wc, fr, fq); S.done(cur); }
        if (!has_next) break;
#pragma unroll
        for (int a = 0; a < 2; ++a)
#pragma unroll
            for (int b = 0; b < 2; ++b)
#pragma unroll
                for (int m = 0; m < 4; ++m)
#pragma unroll
                    for (int n = 0; n < 2; ++n) acc[a][b][m][n] = (f32x4){0.f, 0.f, 0.f, 0.f};
        cur = nxt; cA = nA; cB = nB; ++ui;
        if constexpr (ALIGN_EPI) { if (wr == 1) PG8_BAR; }
    }
    PG8_WAIT_V(0);
    if constexpr (!ALIGN_EPI) { if (wr == 0) PG8_BAR; }
    PG8_BAR;
#undef PG8_SA
#undef PG8_SB
#undef PG8_STAGE
#undef PG8_LDA
#undef PG8_LDB
#undef PG8_MMA
#undef PG8_WAIT_V
#undef PG8_WAIT_L
#undef PG8_BAR
#undef PG8_SCHED
}
}

__device__ __forceinline__ void phase_mod(const Params& p, unsigned char* lds, const int layer, const int wb0, const int nwb) {
    const int tid = threadIdx.x;
    float* sc = (float*)lds;
    float* red = (float*)(lds + 40960);
    float* modv = (float*)(p.ws + WS_MODV);
    __syncthreads();
    for (int e = tid; e < 5 * D; e += 512) { const int r = e / D, k = e % D; const float v = r < 4 ? p.c[r * D + k] : p.c_ctx[k]; sc[e] = siluf_(v); }
    __syncthreads();
    for (int it = (int)blockIdx.x - wb0; it < 256; it += nwb) {
        const int l = layer, n0 = it * 48;
        const int kg = tid / 12, cg_ = tid % 12;
        float acc[5][4];
#pragma unroll
        for (int r = 0; r < 5; ++r)
#pragma unroll
            for (int j = 0; j < 4; ++j) acc[r][j] = 0.f;
        if (kg < 42) {
            const float* wp = p.mod_w + (size_t)l * D * (6 * D) + n0 + 4 * cg_;
#pragma unroll 4
            for (int k = kg; k < D; k += 42) {
                const f32x4 w = *(const f32x4*)(wp + (size_t)k * (6 * D));
#pragma unroll
                for (int r = 0; r < 5; ++r) { const float s = sc[r * D + k];
#pragma unroll
                    for (int j = 0; j < 4; ++j) acc[r][j] += s * w[j]; }
            }
#pragma unroll
            for (int r = 0; r < 5; ++r)
#pragma unroll
                for (int j = 0; j < 4; ++j) red[(kg * 5 + r) * 48 + 4 * cg_ + j] = acc[r][j];
        }
        __syncthreads();
        if (tid < 240) { const int r = tid / 48, n = tid % 48; float s = p.mod_b[l * (6 * D) + n0 + n];
            for (int q = 0; q < 42; ++q) s += red[(q * 5 + r) * 48 + n];
            modv[((size_t)l * 5 + r) * (6 * D) + n0 + n] = s; }
        __syncthreads();
    }
    if (layer == 0 && blockIdx.x == gridDim.x - 1) {
        f32x2* tab = (f32x2*)(p.ws + WS_ROPE);
        for (int e = tid; e < 64 * 32; e += 512) { const int pos = e >> 5, i = e & 31;
            const float inv = exp2f(-(float)i * (13.287712379549449f / 32.f));
            const float ang = (float)pos * inv;
            tab[e] = (f32x2){__cosf(ang), __sinf(ang)}; }
    }
}

__device__ __forceinline__ void transpose_item(const float* W, int K, int N, bf16_t* WT, int kb, int n0, int dst_n0, float* scr, int lane) {
    const int k0 = 64 * kb;
    float wv[32];
#pragma unroll
    for (int i = 0; i < 32; ++i) wv[i] = W[(size_t)(k0 + 2 * i + (lane >> 5)) * N + n0 + (lane & 31)];
#pragma unroll
    for (int i = 0; i < 32; ++i) scr[(2 * i + (lane >> 5)) * 33 + (lane & 31)] = wv[i];
    asm volatile("s_waitcnt lgkmcnt(0)" ::: "memory");
    const int c = lane & 7;
#pragma unroll
    for (int j = 0; j < 4; ++j) { const int n = (lane >> 3) + 8 * j; const float* s = scr + (8 * c) * 33 + n;
        u32x4 o; o.x = pk2(s[0 * 33], s[1 * 33]); o.y = pk2(s[2 * 33], s[3 * 33]); o.z = pk2(s[4 * 33], s[5 * 33]); o.w = pk2(s[6 * 33], s[7 * 33]);
        *(u32x4*)(WT + (size_t)(dst_n0 + n) * K + k0 + 8 * c) = o; }
    asm volatile("s_waitcnt lgkmcnt(0)" ::: "memory");
}
__device__ __forceinline__ void modulate_row(const float* xr, const float* g, const float* shift, const float* scale, bf16_t* dst, int lane, const float* part, const float* cgate, float* xw) {
    f32x4 v[8]; float ss = 0.f;
#pragma unroll
    for (int j = 0; j < 8; ++j) { const int c = 256 * j + 4 * lane; v[j] = *(const f32x4*)(xr + c);
        if (part) { f32x4 a = *(const f32x4*)(part + c);
#pragma unroll
            for (int sp = 1; sp < 8; ++sp) a += *(const f32x4*)(part + (size_t)sp * MCTX * D + c);
            v[j] += *(const f32x4*)(cgate + c) * a; *(f32x4*)(xw + c) = v[j]; }
        ss += (v[j].x * v[j].x + v[j].y * v[j].y) + (v[j].z * v[j].z + v[j].w * v[j].w); }
    const float rstd = rsqrtf(wave_sum(ss) * (1.f / D) + EPS);
#pragma unroll
    for (int j = 0; j < 8; ++j) { const int c = 256 * j + 4 * lane;
        const f32x4 gg = *(const f32x4*)(g + c), sh = *(const f32x4*)(shift + c), sc = *(const f32x4*)(scale + c);
        const f32x4 o = v[j] * rstd * gg * (sc + 1.f) + sh;
        u32x2 w; w.x = pk2(o.x, o.y); w.y = pk2(o.z, o.w); *(u32x2*)(dst + c) = w; }
}
__device__ __forceinline__ void phase_modulate(const Params& p, const float* xl, const float* xc, const float* g, int layer, int which, int nrows, int cslot, int clayer) {
    const int lane = threadIdx.x & 63, gw = blockIdx.x * 8 + (threadIdx.x >> 6), NGW = gridDim.x * 8;
    const float* modv = (const float*)(p.ws + WS_MODV) + (size_t)layer * 5 * (6 * D);
    const float* cgate = (const float*)(p.ws + WS_MODV) + ((size_t)clayer * 5 + 4) * (6 * D) + (cslot < 0 ? 0 : cslot) * D;
    bf16_t* A = (bf16_t*)(p.ws + WS_A);
    for (int m = gw; m < nrows; m += NGW) {
        const bool isl = m < MLAT; const int bidx = isl ? (m >> 12) : 4;
        const float* xr = isl ? xl + (size_t)m * D : xc + (size_t)(m - MLAT) * D;
        const float* mv = modv + (size_t)bidx * (6 * D) + which * 3 * D;
        const float* part = (!isl && cslot >= 0) ? (const float*)(p.ws + WS_PART) + (size_t)(m - MLAT) * D : nullptr;
        float* xw = (float*)(p.ws + WS_XC) + (size_t)(isl ? 0 : m - MLAT) * D;
        modulate_row(xr, g, mv, mv + D, A + (size_t)m * D, lane, part, cgate, xw);
    }
}
__device__ __forceinline__ void phase_convert(const Params& p, unsigned char* lds, const int part, const int wb0, const int nwb) {
    const int lane = threadIdx.x & 63, wave = threadIdx.x >> 6;
    float* scr = (float*)(lds + wave * 16384);
    const int gw = ((int)blockIdx.x - wb0) * 8 + wave, NGW = nwb * 8;
    constexpr int I_IN = 32 * 161, I_OUT = 32 * 64, I_UP = 32 * 256, I_DN = 128 * 64, I_QKV = 32 * 192, I_NO = 32 * 64;
    bf16_t* win = (bf16_t*)(p.ws + WS_WIN); bf16_t* wout = (bf16_t*)(p.ws + WS_WOUT); bf16_t* wup = (bf16_t*)(p.ws + WS_WUP);
    bf16_t* wdn = (bf16_t*)(p.ws + WS_WDN); bf16_t* wqkv = (bf16_t*)(p.ws + WS_WQKV); bf16_t* wno = (bf16_t*)(p.ws + WS_WNO);
    __syncthreads();
    if (part == 0) {
        for (int it = gw; it < I_IN + I_OUT + I_UP + I_DN; it += NGW) {
            int r = it;
            if (r < I_IN) { const int kb = r / 161, nb = r % 161, n0 = 32 * nb;
                if (n0 >= 1024 && n0 < 2048) { transpose_item(p.ev_w_in, D, 5152, (bf16_t*)(p.ws + WS_WV0), kb, n0, n0 - 1024, scr, lane); continue; }
                const int dn = n0 < 1024 ? n0 : (n0 < 3072 ? n0 - 1024 : (n0 == 3072 ? C_GL : (n0 < 4128 ? n0 - 3104 + C_XR : n0 - 4128 + C_YR)));
                transpose_item(p.ev_w_in, D, 5152, win, kb, n0, dn, scr, lane); continue; } r -= I_IN;
            if (r < I_OUT) { transpose_item(p.ev_w_out, D, D, wout, r / 64, 32 * (r % 64), 32 * (r % 64), scr, lane); continue; } r -= I_OUT;
            if (r < I_UP) { transpose_item(p.mlp_up, D, DFF, wup, r / 256, 32 * (r % 256), 32 * (r % 256), scr, lane); continue; } r -= I_UP;
            transpose_item(p.mlp_down, DFF, D, wdn, r / 64, 32 * (r % 64), 32 * (r % 64), scr, lane);
        }
        for (int m = (int)blockIdx.x - wb0; m < 32; m += nwb) { const float* src = ((m & 1) ? p.w_x : p.w_a) + (size_t)(m >> 1) * 16384; bf16_t* img = (bf16_t*)(p.ws + WS_LRUW) + (size_t)m * (128 * 136);
            for (int e = threadIdx.x; e < 16384; e += 512) { const int ii = e >> 7, j = e & 127; img[j * 136 + ii] = (bf16_t)f2bf(src[e]); }
            for (int e = threadIdx.x; e < 128 * 8; e += 512) img[(e >> 3) * 136 + 128 + (e & 7)] = (bf16_t)0; }
        u32x4* z = (u32x4*)(win + (size_t)4128 * D); const int nz = (NIN - 4128) * D * 2 / 16;
        for (int e = ((int)blockIdx.x - wb0) * 512 + threadIdx.x; e < nz; e += nwb * 512) z[e] = (u32x4){0u, 0u, 0u, 0u};
    } else {
        for (int it = gw; it < I_UP + I_DN + I_QKV + I_NO; it += NGW) {
            int r = it;
            if (r < I_UP) { transpose_item(p.mlp_up + (size_t)D * DFF, D, DFF, wup + (size_t)D * DFF, r / 256, 32 * (r % 256), 32 * (r % 256), scr, lane); continue; } r -= I_UP;
            if (r < I_DN) { transpose_item(p.mlp_down + (size_t)D * DFF, DFF, D, wdn + (size_t)D * DFF, r / 64, 32 * (r % 64), 32 * (r % 64), scr, lane); continue; } r -= I_DN;
            if (r < I_QKV) { transpose_item(p.na_qkv, D, NQKV, wqkv, r / 192, 32 * (r % 192), 32 * (r % 192), scr, lane); continue; } r -= I_QKV;
            transpose_item(p.na_out, D, D, wno, r / 64, 32 * (r % 64), 32 * (r % 64), scr, lane);
        }
    }
    __syncthreads();
}

constexpr int GL_GU = 0, GL_GB = 8192, GL_TAB = 8704, GL_GBUF = 25088, GL_TOT = 58880, GL_BLE = 60928, GL_QE = 61440, GL_KE = 78848, GL_VT = 96256, GL_ATT = 105472, GL_ST = 114688, GL_END = 132096;
static_assert(GL_END <= LDS_BYTES, "gla lds");
#define GLA_ROW(ci, ii, row, tok, isl) do { isl = (ci) >= 4; const int cc_ = isl ? (ci) - 4 : (ci); const int n_ = isl ? SEQ : CTX; const int pos_ = cc_ * 64 + (ii); \
        tok = dir ? n_ - 1 - pos_ : pos_; row = isl ? (size_t)b * SEQ + tok : (size_t)MLAT + b * CTX + tok; } while (0)
__device__ __forceinline__ void gla_pre(const Params& p, unsigned char* lds) {
    const int tid = threadIdx.x, lane = tid & 63, w = __builtin_amdgcn_readfirstlane(tid >> 6);
    float* gu = (float*)(lds + GL_GU); float* gbv = (float*)(lds + GL_GB); f32x2* tab = (f32x2*)(lds + GL_TAB);
    float* gbuf = (float*)(lds + GL_GBUF); float* tot = (float*)(lds + GL_TOT);
    bf16_t* qe = (bf16_t*)(lds + GL_QE); bf16_t* ke = (bf16_t*)(lds + GL_KE); bf16_t* att = (bf16_t*)(lds + GL_ATT);
    const bf16_t* P = (const bf16_t*)(p.ws + WS_P);
    bf16_t* GQ = (bf16_t*)(p.ws + WS_GQ); bf16_t* GK = (bf16_t*)(p.ws + WS_GK); bf16_t* GA = (bf16_t*)(p.ws + WS_GATT); float* GE = (float*)(p.ws + WS_GBLE);
    const int i = tid >> 3, dg = tid & 7;
    const int fr = lane & 15, fq = lane >> 4;
    __syncthreads();
    { const f32x2* rt = (const f32x2*)(p.ws + WS_ROPE); for (int e = tid; e < 2048; e += 512) tab[e] = rt[e]; }
    for (int it = blockIdx.x; it < 32 * 68; it += gridDim.x) {
        const int chain = it / 68, ci = it % 68; const int dir = chain & 1, h = (chain >> 1) & 3, b = chain >> 3;
        __syncthreads();
        for (int e = tid; e < 2048; e += 512) { const int r = e >> 7, d = e & 127; gu[e] = p.gate_up[(dir * 16 + r) * 512 + h * 128 + d]; }
        if (tid < 128) gbv[tid] = p.gate_b[dir * 512 + h * 128 + tid];
        bool isl; int tok; size_t row; GLA_ROW(ci, i, row, tok, isl);
        const bf16_t* pr = P + row * NIN;
        const u32x4 rq0 = *(const u32x4*)(pr + C_Q + h * 128 + dg * 16), rq1 = *(const u32x4*)(pr + C_Q + h * 128 + dg * 16 + 8);
        const u32x4 rqp0 = *(const u32x4*)(pr + C_Q + h * 128 + (dg ^ 2) * 16), rqp1 = *(const u32x4*)(pr + C_Q + h * 128 + (dg ^ 2) * 16 + 8);
        const u32x4 rk0 = *(const u32x4*)(pr + C_K + h * 128 + dg * 16), rk1 = *(const u32x4*)(pr + C_K + h * 128 + dg * 16 + 8);
        const u32x4 rkp0 = *(const u32x4*)(pr + C_K + h * 128 + (dg ^ 2) * 16), rkp1 = *(const u32x4*)(pr + C_K + h * 128 + (dg ^ 2) * 16 + 8);
        const u32x4 rg0 = *(const u32x4*)(pr + C_GL + dir * 16), rg1 = *(const u32x4*)(pr + C_GL + dir * 16 + 8);
        __syncthreads();
        {
            float gl[16]; unpack8(rg0, gl); unpack8(rg1, gl + 8);
            float z[16];
#pragma unroll
            for (int j = 0; j < 16; ++j) z[j] = gbv[dg * 16 + j];
#pragma unroll
            for (int r = 0; r < 16; ++r) {
#pragma unroll
                for (int j4 = 0; j4 < 4; ++j4) { const f32x4 u4 = *(const f32x4*)(gu + r * 128 + dg * 16 + 4 * j4);
                    z[4 * j4 + 0] += gl[r] * u4.x; z[4 * j4 + 1] += gl[r] * u4.y; z[4 * j4 + 2] += gl[r] * u4.z; z[4 * j4 + 3] += gl[r] * u4.w; }
            }
#pragma unroll
            for (int j4 = 0; j4 < 4; ++j4) { f32x4 o; o.x = logsigf_(z[4 * j4]) * 0.0625f; o.y = logsigf_(z[4 * j4 + 1]) * 0.0625f; o.z = logsigf_(z[4 * j4 + 2]) * 0.0625f; o.w = logsigf_(z[4 * j4 + 3]) * 0.0625f;
                *(f32x4*)(gbuf + i * 132 + dg * 16 + 4 * j4) = o; }
        }
        __syncthreads();
        { const int d = tid & 127, seg = tid >> 7; float run = 0.f;
#pragma unroll
          for (int ii = 0; ii < 16; ++ii) { float* gp = gbuf + (seg * 16 + ii) * 132 + d; run += *gp; *gp = run; }
          tot[seg * 128 + d] = run; }
        __syncthreads();
        {
            const int seg = i >> 4;
            float q[16], qp[16], k[16], kp[16];
            unpack8(rq0, q); unpack8(rq1, q + 8); unpack8(rqp0, qp); unpack8(rqp1, qp + 8);
            unpack8(rk0, k); unpack8(rk1, k + 8); unpack8(rkp0, kp); unpack8(rkp1, kp + 8);
            const float qs = 0.08838834764831845f;
            if (isl) {
                const int posr = (dg < 4) ? (tok >> 6) : (tok & 63);
                const float sgn = (dg & 2) ? 1.f : -1.f;
                const f32x2* tp = tab + posr * 32 + (dg & 1) * 16;
#pragma unroll
                for (int j = 0; j < 16; ++j) { const f32x2 cs = tp[j];
                    q[j] = q[j] * cs.x + sgn * qp[j] * cs.y; k[j] = k[j] * cs.x + sgn * kp[j] * cs.y; }
            }
            unsigned qw[8], kw[8];
#pragma unroll
            for (int j2 = 0; j2 < 8; ++j2) {
                const int d0 = dg * 16 + 2 * j2;
                float b0 = gbuf[i * 132 + d0], b1 = gbuf[i * 132 + d0 + 1];
                if (seg > 0) { b0 += tot[d0]; b1 += tot[d0 + 1]; }
                if (seg > 1) { b0 += tot[128 + d0]; b1 += tot[128 + d0 + 1]; }
                if (seg > 2) { b0 += tot[256 + d0]; b1 += tot[256 + d0 + 1]; }
                const float e0 = __expf(b0), e1 = __expf(b1), n0 = __expf(-b0), n1 = __expf(-b1);
                if (i == 63) { GE[(size_t)it * 128 + d0] = e0; GE[(size_t)it * 128 + d0 + 1] = e1; }
                qw[j2] = pk2(q[2 * j2] * qs * e0, q[2 * j2 + 1] * qs * e1);
                kw[j2] = pk2(k[2 * j2] * n0, k[2 * j2 + 1] * n1);
            }
            const u32x4 q0 = (u32x4){qw[0], qw[1], qw[2], qw[3]}, q1 = (u32x4){qw[4], qw[5], qw[6], qw[7]}, k0 = (u32x4){kw[0], kw[1], kw[2], kw[3]}, k1 = (u32x4){kw[4], kw[5], kw[6], kw[7]};
            *(u32x4*)(qe + i * 136 + dg * 16) = q0; *(u32x4*)(qe + i * 136 + dg * 16 + 8) = q1;
            *(u32x4*)(ke + i * 136 + dg * 16) = k0; *(u32x4*)(ke + i * 136 + dg * 16 + 8) = k1;
            bf16_t* gq = GQ + (size_t)it * 8192 + i * 128 + dg * 16; bf16_t* gk = GK + (size_t)it * 8192 + i * 128 + dg * 16;
            *(u32x4*)gq = q0; *(u32x4*)(gq + 8) = q1; *(u32x4*)gk = k0; *(u32x4*)(gk + 8) = k1;
        }
        __syncthreads();
        {
            const int tr = w >> 1;
#pragma unroll
            for (int c2 = 0; c2 < 2; ++c2) { const int tc = (w & 1) * 2 + c2;
                f32x4 a = (f32x4){0.f, 0.f, 0.f, 0.f};
                if (tc <= tr) {
#pragma unroll
                    for (int ks = 0; ks < 4; ++ks) { const bf16x8 A = *(const bf16x8*)(qe + (tr * 16 + fr) * 136 + ks * 32 + fq * 8); const bf16x8 B = *(const bf16x8*)(ke + (tc * 16 + fr) * 136 + ks * 32 + fq * 8);
                        a = __builtin_amdgcn_mfma_f32_16x16x32_bf16(A, B, a, 0, 0, 0); }
                }
#pragma unroll
                for (int j = 0; j < 4; ++j) { const int t = tr * 16 + fq * 4 + j, s2 = tc * 16 + fr; const float v = (s2 <= t) ? a[j] : 0.f; att[t * 72 + s2] = (bf16_t)f2bf(v); }
            }
        }
        __syncthreads();
        { const int t = tid >> 3, c8 = tid & 7; *(u32x4*)(GA + (size_t)it * 4096 + t * 64 + c8 * 8) = *(const u32x4*)(att + t * 72 + c8 * 8); }
    }
    __syncthreads();
}
__device__ __forceinline__ void gla_seq(const Params& p, unsigned char* lds, int gb) {
    const int tid = threadIdx.x, lane = tid & 63, w = __builtin_amdgcn_readfirstlane(tid >> 6);
    const int dvs = gb & 3, dir = (gb >> 2) & 1, h = (gb >> 3) & 3, b = gb >> 5;
    const int chain = (b * 4 + h) * 2 + dir;
    float* blE = (float*)(lds + GL_BLE); float* ostg = (float*)(lds + GL_GBUF);
    bf16_t* qe = (bf16_t*)(lds + GL_QE); bf16_t* ke = (bf16_t*)(lds + GL_KE); bf16_t* vt = (bf16_t*)(lds + GL_VT);
    bf16_t* att = (bf16_t*)(lds + GL_ATT); bf16_t* St = (bf16_t*)(lds + GL_ST);
    const bf16_t* GQ = (const bf16_t*)(p.ws + WS_GQ) + (size_t)chain * 68 * 8192; const bf16_t* GK = (const bf16_t*)(p.ws + WS_GK) + (size_t)chain * 68 * 8192;
    const bf16_t* GA = (const bf16_t*)(p.ws + WS_GATT) + (size_t)chain * 68 * 4096; const float* GE = (const float*)(p.ws + WS_GBLE) + (size_t)chain * 68 * 128;
    bf16_t* obuf = (bf16_t*)(p.ws + (dir ? WS_OB : WS_OF));
    const int i = tid >> 3, dg = tid & 7;
    const int fr = lane & 15, fq = lane >> 4;
    const bf16_t* VT = (const bf16_t*)(p.ws + WS_VT) + (size_t)(h * 256 + dvs * 64 + i) * MALL;
    __syncthreads();
    for (int e = tid; e < 64 * 136 / 2; e += 512) ((unsigned*)St)[e] = 0u;
    f32x4 S[4];
#pragma unroll
    for (int q = 0; q < 4; ++q) S[q] = (f32x4){0.f, 0.f, 0.f, 0.f};
    u32x4 RA[6], RB[6]; float reA, reB;
#define GS_LOAD(R, re, ci) do { const bf16_t* gq = GQ + (size_t)(ci) * 8192 + i * 128 + dg * 16; const bf16_t* gk = GK + (size_t)(ci) * 8192 + i * 128 + dg * 16; \
        R[0] = *(const u32x4*)gq; R[1] = *(const u32x4*)(gq + 8); R[2] = *(const u32x4*)gk; R[3] = *(const u32x4*)(gk + 8); \
        R[4] = *(const u32x4*)(GA + (size_t)(ci) * 4096 + i * 64 + dg * 8); \
        { const bool isl_ = (ci) >= 4; const int cc2_ = isl_ ? (ci) - 4 : (ci); const int n2_ = isl_ ? SEQ : CTX; const int tlo_ = dir ? n2_ - 64 - cc2_ * 64 : cc2_ * 64; \
          R[5] = *(const u32x4*)(VT + (isl_ ? (size_t)b * SEQ : (size_t)MLAT + b * CTX) + tlo_ + 8 * dg); } \
        re = (tid < 128) ? GE[(size_t)(ci) * 128 + tid] : 0.f; } while (0)
#define GS_BODY(R, re, ci) do { \
        *(u32x4*)(qe + i * 136 + dg * 16) = R[0]; *(u32x4*)(qe + i * 136 + dg * 16 + 8) = R[1]; \
        *(u32x4*)(ke + i * 136 + dg * 16) = R[2]; *(u32x4*)(ke + i * 136 + dg * 16 + 8) = R[3]; \
        *(u32x4*)(att + i * 72 + dg * 8) = R[4]; \
        if (dir == 0) *(u32x4*)(vt + i * 72 + 8 * dg) = R[5]; \
        else { u32x4 o; o.x = (R[5].w >> 16) | (R[5].w << 16); o.y = (R[5].z >> 16) | (R[5].z << 16); o.z = (R[5].y >> 16) | (R[5].y << 16); o.w = (R[5].x >> 16) | (R[5].x << 16); *(u32x4*)(vt + i * 72 + 56 - 8 * dg) = o; } \
        if (tid < 128) blE[tid] = re; \
        if ((ci) + 2 < 68) GS_LOAD(R, re, (ci) + 2); \
        __syncthreads(); \
        { \
            const int tr = w >> 1; \
            _Pragma("unroll") for (int c2 = 0; c2 < 2; ++c2) { const int vc = (w & 1) * 2 + c2; \
                f32x4 a = (f32x4){0.f, 0.f, 0.f, 0.f}; \
                _Pragma("unroll") for (int ks = 0; ks < 4; ++ks) { const bf16x8 A = *(const bf16x8*)(qe + (tr * 16 + fr) * 136 + ks * 32 + fq * 8); const bf16x8 B = *(const bf16x8*)(St + (vc * 16 + fr) * 136 + ks * 32 + fq * 8); \
                    a = __builtin_amdgcn_mfma_f32_16x16x32_bf16(A, B, a, 0, 0, 0); } \
                _Pragma("unroll") for (int ks = 0; ks < 2; ++ks) { const bf16x8 A = *(const bf16x8*)(att + (tr * 16 + fr) * 72 + ks * 32 + fq * 8); const bf16x8 B = *(const bf16x8*)(vt + (vc * 16 + fr) * 72 + ks * 32 + fq * 8); \
                    a = __builtin_amdgcn_mfma_f32_16x16x32_bf16(A, B, a, 0, 0, 0); } \
                _Pragma("unroll") for (int j = 0; j < 4; ++j) ostg[(tr * 16 + fq * 4 + j) * 68 + vc * 16 + fr] = a[j]; \
            } \
            _Pragma("unroll") for (int ks = 0; ks < 2; ++ks) { \
                bf16x8 A; \
                _Pragma("unroll") for (int j = 0; j < 8; ++j) A[j] = (short)ke[(ks * 32 + fq * 8 + j) * 136 + 16 * w + fr]; \
                _Pragma("unroll") for (int vc = 0; vc < 4; ++vc) { const bf16x8 B = *(const bf16x8*)(vt + (vc * 16 + fr) * 72 + ks * 32 + fq * 8); \
                    S[vc] = __builtin_amdgcn_mfma_f32_16x16x32_bf16(A, B, S[vc], 0, 0, 0); } \
            } \
            const f32x4 sc = *(const f32x4*)(blE + 16 * w + fq * 4); \
            _Pragma("unroll") for (int vc = 0; vc < 4; ++vc) S[vc] = S[vc] * sc; \
        } \
        __syncthreads(); \
        _Pragma("unroll") for (int vc = 0; vc < 4; ++vc) { u32x2 o; o.x = pk2(S[vc][0], S[vc][1]); o.y = pk2(S[vc][2], S[vc][3]); *(u32x2*)(St + (vc * 16 + fr) * 136 + 16 * w + fq * 4) = o; } \
        { bool isl2; int tok2; size_t row2; GLA_ROW(ci, i, row2, tok2, isl2);     \
          bf16_t* od = obuf + row2 * 1024 + h * 256 + dvs * 64 + dg * 8; \
          const f32x4 o0_ = *(const f32x4*)(ostg + i * 68 + dg * 8), o1_ = *(const f32x4*)(ostg + i * 68 + dg * 8 + 4); \
          *(u32x4*)od = (u32x4){pk2(o0_[0], o0_[1]), pk2(o0_[2], o0_[3]), pk2(o1_[0], o1_[1]), pk2(o1_[2], o1_[3])}; } \
    } while (0)
    GS_LOAD(RA, reA, 0); GS_LOAD(RB, reB, 1);
    for (int ci = 0; ci < 68; ci += 2) { GS_BODY(RA, reA, ci); GS_BODY(RB, reB, ci + 1); }
    __syncthreads();
#undef GS_LOAD
#undef GS_BODY
}

constexpr int LR_BA = 0, LR_BX = 34816, LR_XCB = 69632, LR_XC32 = 87040, LR_CW = 120832, LR_END = 123392;
static_assert(LR_END <= LDS_BYTES, "lru lds");
constexpr size_t DO_PC0 = 0, DO_PC1 = 34 * MiB, DO_TOT = 68 * MiB;
__device__ __forceinline__ float expm1_neg(float x) {
    return (x > -0.02f) ? x * (1.f + x * (0.5f + x * (0.16666667f + x * 0.041666667f))) : __expf(x) - 1.f;
}
__device__ __forceinline__ void lru_pre(const Params& p, unsigned char* lds) {
    const int tid = threadIdx.x, lane = tid & 63, w = __builtin_amdgcn_readfirstlane(tid >> 6);
    const int dgi = blockIdx.x & 15, sub = blockIdx.x >> 4, nsub = (gridDim.x - dgi + 15) >> 4;
    const int g = dgi & 7, dir = dgi >> 3, c0 = 128 * g;
    bf16_t* Ba = (bf16_t*)(lds + LR_BA); bf16_t* Bx = (bf16_t*)(lds + LR_BX); bf16_t* xcb = (bf16_t*)(lds + LR_XCB);
    float* xc32 = (float*)(lds + LR_XC32); float* cw = (float*)(lds + LR_CW);
    const bf16_t* P = (const bf16_t*)(p.ws + WS_P);
    bf16_t* hbuf = (bf16_t*)(p.ws + (dir ? WS_HB : WS_HF));
    bf16_t* pcbuf = (bf16_t*)((unsigned char*)p.out + (dir ? DO_PC1 : DO_PC0));
    float* totP = (float*)((unsigned char*)p.out + DO_TOT); float* totH = totP + (size_t)8 * 68 * 1024;
    __syncthreads();
    { const u32x4* img = (const u32x4*)(p.ws + WS_LRUW + (size_t)(dir * 8 + g) * 2 * (128 * 136 * 2)); u32x4* dst = (u32x4*)Ba;
      u32x4 wimg[9];
#pragma unroll
      for (int q = 0; q < 9; ++q) { const int e = tid + 512 * q; wimg[q] = e < 2 * 34816 / 16 ? img[e] : (u32x4){0u, 0u, 0u, 0u}; }
#pragma unroll
      for (int q = 0; q < 9; ++q) { const int e = tid + 512 * q; if (e < 2 * 34816 / 16) dst[e] = wimg[q]; } }
    for (int e = tid; e < 640; e += 512) { const int j = e >> 7, c = e & 127; cw[e] = j < 4 ? p.conv_w[j * 1024 + c0 + c] : p.conv_b[c0 + c]; }
    __syncthreads();
    const int fr = lane & 15, fq = lane >> 4;
    const int ch = c0 + 16 * w + fr;
    const float ba = p.b_a[dir * 1024 + ch], bx = p.b_x[dir * 1024 + ch];
    const float ls8 = 8.f * logsigf_(p.lam[dir * 1024 + ch]);
    bf16x8 WA[4], WX[4];
#pragma unroll
    for (int ks = 0; ks < 4; ++ks) { WA[ks] = *(const bf16x8*)(Ba + (16 * w + fr) * 136 + ks * 32 + fq * 8); WX[ks] = *(const bf16x8*)(Bx + (16 * w + fr) * 136 + ks * 32 + fq * 8); }
    __syncthreads();
    bf16_t* hst = Ba; bf16_t* pst = Bx;
    const int i = tid >> 3, cgp = tid & 7;
    u32x4 rx[4][2];
#define LRU_LOAD(idx) do { const int b_ = (idx) / 68, ci_ = (idx) % 68; const bool isl_ = ci_ >= 4; const int cc_ = isl_ ? ci_ - 4 : ci_; const int n_ = isl_ ? SEQ : CTX; const int pos_ = cc_ * 64 + i; \
        const int tok_ = dir ? n_ - 1 - pos_ : pos_; const size_t rb_ = isl_ ? (size_t)b_ * SEQ : (size_t)MLAT + b_ * CTX; \
        _Pragma("unroll") for (int j = 0; j < 4; ++j) { const int tt_ = tok_ + j - 2; \
            if (tt_ >= 0 && tt_ < n_) { const bf16_t* pr = P + (rb_ + tt_) * NIN + C_XR + c0 + cgp * 16; rx[j][0] = *(const u32x4*)pr; rx[j][1] = *(const u32x4*)(pr + 8); } \
            else { rx[j][0] = (u32x4){0u, 0u, 0u, 0u}; rx[j][1] = (u32x4){0u, 0u, 0u, 0u}; } } } while (0)
    if (sub < 272) LRU_LOAD(sub);
    for (int idx = sub; idx < 272; idx += nsub) {
        const int b = idx / 68, ci = idx % 68;
        const bool isl = ci >= 4; const int cc = isl ? ci - 4 : ci; const int n = isl ? SEQ : CTX; const size_t rb = isl ? (size_t)b * SEQ : (size_t)MLAT + b * CTX;
        {
            float xc[16];
#pragma unroll
            for (int j = 0; j < 16; ++j) xc[j] = cw[4 * 128 + cgp * 16 + j];
#pragma unroll
            for (int t4 = 0; t4 < 4; ++t4) { float xv[16]; unpack8(rx[t4][0], xv); unpack8(rx[t4][1], xv + 8);
#pragma unroll
                for (int j = 0; j < 16; ++j) xc[j] += xv[j] * cw[t4 * 128 + cgp * 16 + j]; }
#pragma unroll
            for (int j4 = 0; j4 < 4; ++j4) *(f32x4*)(xc32 + i * 132 + cgp * 16 + 4 * j4) = (f32x4){xc[4 * j4], xc[4 * j4 + 1], xc[4 * j4 + 2], xc[4 * j4 + 3]};
            *(u32x4*)(xcb + i * 136 + cgp * 16) = (u32x4){pk2(xc[0], xc[1]), pk2(xc[2], xc[3]), pk2(xc[4], xc[5]), pk2(xc[6], xc[7])};
            *(u32x4*)(xcb + i * 136 + cgp * 16 + 8) = (u32x4){pk2(xc[8], xc[9]), pk2(xc[10], xc[11]), pk2(xc[12], xc[13]), pk2(xc[14], xc[15])};
            if (idx + nsub < 272) LRU_LOAD(idx + nsub);
        }
        __syncthreads();
        float hcar = 0.f, pcar = 1.f;
#pragma unroll
        for (int tt = 0; tt < 4; ++tt) {
            f32x4 ar = (f32x4){0.f, 0.f, 0.f, 0.f}, ai = (f32x4){0.f, 0.f, 0.f, 0.f};
#pragma unroll
            for (int ks = 0; ks < 4; ++ks) { const bf16x8 A = *(const bf16x8*)(xcb + (tt * 16 + fr) * 136 + ks * 32 + fq * 8);
                ar = __builtin_amdgcn_mfma_f32_16x16x32_bf16(A, WA[ks], ar, 0, 0, 0); ai = __builtin_amdgcn_mfma_f32_16x16x32_bf16(A, WX[ks], ai, 0, 0, 0); }
            float Pj[4], Hj[4];
            float Pl = 1.f, Hl = 0.f;
#pragma unroll
            for (int j = 0; j < 4; ++j) { const int ii = tt * 16 + fq * 4 + j;
                const float r = sigmoidf_(ar[j] + ba), ig = sigmoidf_(ai[j] + bx);
                const float la = r * ls8; const float a = __expf(la);
                const float xcv = xc32[ii * 132 + 16 * w + fr];
                const float u = sqrtf(fmaxf(-expm1_neg(2.f * la), 0.f)) * (ig * xcv);
                Pl = a * Pl; Hl = a * Hl + u; Pj[j] = Pl; Hj[j] = Hl; }
            float Pi = Pl, Hi = Hl;
            { const float Pp = __shfl_up(Pi, 16), Hp = __shfl_up(Hi, 16); if (fq >= 1) { Hi = Pi * Hp + Hi; Pi = Pp * Pi; } }
            { const float Pp = __shfl_up(Pi, 32), Hp = __shfl_up(Hi, 32); if (fq >= 2) { Hi = Pi * Hp + Hi; Pi = Pp * Pi; } }
            float Pe = __shfl_up(Pi, 16), He = __shfl_up(Hi, 16); if (fq == 0) { Pe = 1.f; He = 0.f; }
            const float sin_ = Pe * hcar + He, pin_ = Pe * pcar;
            const float Pt = __shfl(Pi, 48 + fr), Ht = __shfl(Hi, 48 + fr);
#pragma unroll
            for (int j = 0; j < 4; ++j) { const int ii = tt * 16 + fq * 4 + j; const int pos = cc * 64 + ii; const int tok = dir ? n - 1 - pos : pos;
                hst[ii * 136 + 16 * w + fr] = (bf16_t)f2bf(Pj[j] * sin_ + Hj[j]);
                pst[ii * 136 + 16 * w + fr] = (bf16_t)f2bf(Pj[j] * pin_); }
            hcar = Pt * hcar + Ht; pcar = Pt * pcar;
        }
        if (fq == 0) { const size_t to = ((size_t)(b * 2 + dir) * 68 + ci) * 1024 + ch; totP[to] = pcar; totH[to] = hcar; }
        __syncthreads();
        { const int pos = cc * 64 + i; const int tok = dir ? n - 1 - pos : pos; const size_t go = (rb + tok) * 1024 + c0 + cgp * 16;
          const u32x4 h0 = *(const u32x4*)(hst + i * 136 + cgp * 16), h1 = *(const u32x4*)(hst + i * 136 + cgp * 16 + 8);
          const u32x4 p0 = *(const u32x4*)(pst + i * 136 + cgp * 16), p1 = *(const u32x4*)(pst + i * 136 + cgp * 16 + 8);
          *(u32x4*)(hbuf + go) = h0; *(u32x4*)(hbuf + go + 8) = h1; *(u32x4*)(pcbuf + go) = p0; *(u32x4*)(pcbuf + go + 8) = p1; }
    }
#undef LRU_LOAD
}
__device__ __forceinline__ void lru_apply(const Params& p, int role) {
    const int tid = threadIdx.x;
    const int cg64 = role & 15, dir = (role >> 4) & 1, b = role >> 5;
    const int i = tid >> 3, c8 = tid & 7; const int ch = cg64 * 64 + c8 * 8;
    bf16_t* hbuf = (bf16_t*)(p.ws + (dir ? WS_HB : WS_HF));
    const bf16_t* pcbuf = (const bf16_t*)((const unsigned char*)p.out + (dir ? DO_PC1 : DO_PC0));
    const float* totP = (const float*)((const unsigned char*)p.out + DO_TOT) + (size_t)(b * 2 + dir) * 68 * 1024 + ch; const float* totH = totP + (size_t)8 * 68 * 1024;
    float cin[8];
#pragma unroll
    for (int j = 0; j < 8; ++j) cin[j] = 0.f;
    for (int c4 = 0; c4 < 68; c4 += 4) {
        u32x4 pw[4], hw[4]; f32x4 tp[4][2], th[4][2]; size_t off[4];
#pragma unroll
        for (int q = 0; q < 4; ++q) { const int ci = c4 + q;
            const bool isl = ci >= 4; const int cc = isl ? ci - 4 : ci; const int n = isl ? SEQ : CTX; const size_t rb = isl ? (size_t)b * SEQ : (size_t)MLAT + b * CTX;
            const int pos = cc * 64 + i; const int tok = dir ? n - 1 - pos : pos;
            off[q] = (rb + tok) * 1024 + ch;
            pw[q] = *(const u32x4*)(pcbuf + off[q]); hw[q] = *(const u32x4*)(hbuf + off[q]);
            tp[q][0] = *(const f32x4*)(totP + (size_t)ci * 1024); tp[q][1] = *(const f32x4*)(totP + (size_t)ci * 1024 + 4);
            th[q][0] = *(const f32x4*)(totH + (size_t)ci * 1024); th[q][1] = *(const f32x4*)(totH + (size_t)ci * 1024 + 4); }
#pragma unroll
        for (int q = 0; q < 4; ++q) {
            float pc[8], hl[8]; unpack8(pw[q], pc); unpack8(hw[q], hl);
            float hv[8];
#pragma unroll
            for (int j = 0; j < 8; ++j) hv[j] = pc[j] * cin[j] + hl[j];
            *(u32x4*)(hbuf + off[q]) = (u32x4){pk2(hv[0], hv[1]), pk2(hv[2], hv[3]), pk2(hv[4], hv[5]), pk2(hv[6], hv[7])};
            const float tpv[8] = {tp[q][0].x, tp[q][0].y, tp[q][0].z, tp[q][0].w, tp[q][1].x, tp[q][1].y, tp[q][1].z, tp[q][1].w};
            const float thv[8] = {th[q][0].x, th[q][0].y, th[q][0].z, th[q][0].w, th[q][1].x, th[q][1].y, th[q][1].z, th[q][1].w};
#pragma unroll
            for (int j = 0; j < 8; ++j) cin[j] = tpv[j] * cin[j] + thv[j];
        }
    }
}

__device__ __forceinline__ void phase_merge(const Params& p) {
    const int lane = threadIdx.x & 63, gw = blockIdx.x * 8 + (threadIdx.x >> 6), NGW = gridDim.x * 8;
    const bf16_t* P = (const bf16_t*)(p.ws + WS_P); const bf16_t* of = (const bf16_t*)(p.ws + WS_OF); const bf16_t* ob = (const bf16_t*)(p.ws + WS_OB);
    const bf16_t* hf = (const bf16_t*)(p.ws + WS_HF); const bf16_t* hb = (const bf16_t*)(p.ws + WS_HB); bf16_t* A = (bf16_t*)(p.ws + WS_A);
    for (int m = gw; m < MALL; m += NGW) {
        const bf16_t* pr = P + (size_t)m * NIN;
        u32x2 wf[4], wb[4], og[4], ha[4], hbv[4], yv[4];
#pragma unroll
        for (int h = 0; h < 4; ++h) { const int c = h * 256 + 4 * lane;
            wf[h] = *(const u32x2*)(of + (size_t)m * 1024 + c); wb[h] = *(const u32x2*)(ob + (size_t)m * 1024 + c); og[h] = *(const u32x2*)(pr + C_OG + c);
            ha[h] = *(const u32x2*)(hf + (size_t)m * 1024 + c); hbv[h] = *(const u32x2*)(hb + (size_t)m * 1024 + c); yv[h] = *(const u32x2*)(pr + C_YR + c); }
#pragma unroll
        for (int h = 0; h < 4; ++h) { const int c = h * 256 + 4 * lane;
            const f32x4 o = (f32x4){bflo(wf[h].x) + bflo(wb[h].x), bfhi(wf[h].x) + bfhi(wb[h].x), bflo(wf[h].y) + bflo(wb[h].y), bfhi(wf[h].y) + bfhi(wb[h].y)};
            const float ss = wave_sum((o.x * o.x + o.y * o.y) + (o.z * o.z + o.w * o.w));
            const float rstd = rsqrtf(ss * (1.f / 256.f) + EPS);
            const f32x4 gg = *(const f32x4*)(p.gla_g + c);
            const float r0 = o.x * rstd * gg.x * siluf_(bflo(og[h].x)), r1 = o.y * rstd * gg.y * siluf_(bfhi(og[h].x));
            const float r2 = o.z * rstd * gg.z * siluf_(bflo(og[h].y)), r3 = o.w * rstd * gg.w * siluf_(bfhi(og[h].y));
            *(u32x2*)(A + (size_t)m * D + c) = (u32x2){pk2(r0, r1), pk2(r2, r3)}; }
#pragma unroll
        for (int j = 0; j < 4; ++j) { const int c = 256 * j + 4 * lane;
            const u32x2 a = ha[j], bb = hbv[j], y = yv[j];
            const float r0 = (bflo(a.x) + bflo(bb.x)) * gelu_tanh(bflo(y.x)), r1 = (bfhi(a.x) + bfhi(bb.x)) * gelu_tanh(bfhi(y.x));
            const float r2 = (bflo(a.y) + bflo(bb.y)) * gelu_tanh(bflo(y.y)), r3 = (bfhi(a.y) + bfhi(bb.y)) * gelu_tanh(bfhi(y.y));
            *(u32x2*)(A + (size_t)m * D + 1024 + c) = (u32x2){pk2(r0, r1), pk2(r2, r3)}; }
    }
}

constexpr int NA_KT = 0, NA_VT = 34816, NA_PW = 71680, NA_RB = 108544, NA_END = 110592;
static_assert(NA_END <= LDS_BYTES, "na lds");
__device__ __forceinline__ void phase_na(const Params& p, unsigned char* lds) {
    const int tid = threadIdx.x, lane = tid & 63, w = __builtin_amdgcn_readfirstlane(tid >> 6), fr = lane & 15, fq = lane >> 4;
    bf16_t* KtB = (bf16_t*)(lds + NA_KT); bf16_t* vtB = (bf16_t*)(lds + NA_VT); bf16_t* Pw = (bf16_t*)(lds + NA_PW) + w * (32 * 72); float* rbt = (float*)(lds + NA_RB);
    const bf16_t* QK = (const bf16_t*)(p.ws + WS_P); const bf16_t* VTg = (const bf16_t*)(p.ws + WS_VT); bf16_t* O = (bf16_t*)(p.ws + WS_A);
    const int key = tid >> 3, part = tid & 7;
    const int vd = tid >> 2, vc4 = tid & 3;
    const float scale = 0.08838834764831845f * 1.4426950408889634f;
    for (int u = blockIdx.x; u < 1024; u += gridDim.x) {
        const int r4 = u & 15, h = (u >> 4) & 15, b = u >> 8, r0 = 4 * r4;
        const int rs_lo = min(max(r0 - 4, 0), 56), rs_hi = min(max(r0 - 1, 0), 56);
        const int ntile = 4 + (rs_hi + 8 - rs_lo);
        const int qr = r0 + (w >> 1), qc0 = 32 * (w & 1);
        const int rsq = min(max(qr - 4, 0), 56);
        __syncthreads();
        for (int e = tid; e < 465; e += 512) rbt[e] = p.rel_bias[h * 465 + e] * 1.4426950408889634f;
        bf16x8 aq[2][4];
#pragma unroll
        for (int mt = 0; mt < 2; ++mt) { const bf16_t* qp = QK + (size_t)(b * SEQ + qr * 64 + qc0 + 16 * mt + fr) * NQK + h * 128 + fq * 8;
#pragma unroll
            for (int ks = 0; ks < 4; ++ks) aq[mt][ks] = *(const bf16x8*)(qp + ks * 32); }
        f32x4 Oa[2][8];
#pragma unroll
        for (int mt = 0; mt < 2; ++mt)
#pragma unroll
            for (int dt = 0; dt < 8; ++dt) Oa[mt][dt] = (f32x4){0.f, 0.f, 0.f, 0.f};
        float mrow[2] = {-1e30f, -1e30f}, lrow[2] = {0.f, 0.f};
        u32x4 ra[4];
#define NA_LOAD(R, kt) do { const size_t row0_ = (kt) < 4 ? (size_t)MLAT + b * CTX + (kt) * 64 : (size_t)b * SEQ + (rs_lo + (kt) - 4) * 64; \
        const bf16_t* pk = QK + (row0_ + key) * NQK + D + h * 128 + part * 16; const bf16_t* pv = VTg + (size_t)(h * 128 + vd) * MALL + row0_ + vc4 * 16; \
        R[0] = *(const u32x4*)pk; R[1] = *(const u32x4*)(pk + 8); R[2] = *(const u32x4*)pv; R[3] = *(const u32x4*)(pv + 8); } while (0)
#define NA_WRITE(R, buf) do { bf16_t* kd = KtB + (buf) * (64 * 136) + key * 136 + part * 16; bf16_t* vdp = vtB + (buf) * (128 * 72) + vd * 72 + vc4 * 16; \
        *(u32x4*)kd = R[0]; *(u32x4*)(kd + 8) = R[1]; *(u32x4*)vdp = R[2]; *(u32x4*)(vdp + 8) = R[3]; } while (0)
        NA_LOAD(ra, 0); NA_WRITE(ra, 0);
        NA_LOAD(ra, 1);
        __syncthreads();
        for (int kt = 0; kt < ntile; ++kt) {
            if (kt + 1 < ntile) { NA_WRITE(ra, (kt + 1) & 1); if (kt + 2 < ntile) NA_LOAD(ra, kt + 2); }
            const bool band = kt >= 4; const int kr = rs_lo + kt - 4;
            if (!(band && (kr < rsq || kr >= rsq + 8))) {
                const bf16_t* Kt = KtB + (kt & 1) * (64 * 136); const bf16_t* vt = vtB + (kt & 1) * (128 * 72);
                f32x4 st[2][4];
                const int wlo0 = min(max(qc0 - 8, 0), 48), whi0 = min(max(qc0 + 7, 0), 48) + 16, wlo1 = min(max(qc0 + 8, 0), 48), whi1 = min(max(qc0 + 23, 0), 48) + 16;
#pragma unroll
                for (int nt = 0; nt < 4; ++nt) {
                    const bool act0 = !band || (16 * nt < whi0 && 16 * nt + 16 > wlo0), act1 = !band || (16 * nt < whi1 && 16 * nt + 16 > wlo1);
                    st[0][nt] = (f32x4){0.f, 0.f, 0.f, 0.f}; st[1][nt] = (f32x4){0.f, 0.f, 0.f, 0.f};
                    if (act0 || act1) {
                        bf16x8 Bk[4];
#pragma unroll
                        for (int ks = 0; ks < 4; ++ks) Bk[ks] = *(const bf16x8*)(Kt + (nt * 16 + fr) * 136 + ks * 32 + fq * 8);
#pragma unroll
                        for (int ks = 0; ks < 4; ++ks) {
                            if (act0) st[0][nt] = __builtin_amdgcn_mfma_f32_16x16x32_bf16(Bk[ks], aq[0][ks], st[0][nt], 0, 0, 0);
                            if (act1) st[1][nt] = __builtin_amdgcn_mfma_f32_16x16x32_bf16(Bk[ks], aq[1][ks], st[1][nt], 0, 0, 0); }
                    }
                }
                unsigned pk[2][4][2];
#pragma unroll
                for (int mt = 0; mt < 2; ++mt) {
                    __builtin_amdgcn_sched_barrier(0);
                    const int c = qc0 + 16 * mt + fr; const int cs = min(max(c - 8, 0), 48); const int wlo = mt ? wlo1 : wlo0, whi = mt ? whi1 : whi0;
                    float mx = -1e30f;
#pragma unroll
                    for (int nt = 0; nt < 4; ++nt) {
                        const bool act = !band || (16 * nt < whi && 16 * nt + 16 > wlo);
                        if (act) {
#pragma unroll
                            for (int j = 0; j < 4; ++j) { float v = st[mt][nt][j] * scale;
                                if (band) { const int kc = nt * 16 + fq * 4 + j; const bool valid = kc >= cs && kc < cs + 16; const int dci = min(max(kc - c + 15, 0), 30);
                                    v += rbt[(kr - qr + 7) * 31 + dci]; v = valid ? v : -1e30f; }
                                st[mt][nt][j] = v; mx = fmaxf(mx, v); }
                        }
                    }
                    mx = fmaxf(mx, __shfl_xor(mx, 16)); mx = fmaxf(mx, __shfl_xor(mx, 32));
                    const bool resc = !__all(mx - mrow[mt] <= 8.0f);
                    float mn = mrow[mt], alpha = 1.f;
                    if (resc) { mn = fmaxf(mrow[mt], mx); alpha = __builtin_amdgcn_exp2f(mrow[mt] - mn); mrow[mt] = mn; }
                    float ls = 0.f;
#pragma unroll
                    for (int nt = 0; nt < 4; ++nt) {
                        const bool act = !band || (16 * nt < whi && 16 * nt + 16 > wlo);
                        if (act) { const float p0 = __builtin_amdgcn_exp2f(st[mt][nt][0] - mn), p1 = __builtin_amdgcn_exp2f(st[mt][nt][1] - mn), p2 = __builtin_amdgcn_exp2f(st[mt][nt][2] - mn), p3 = __builtin_amdgcn_exp2f(st[mt][nt][3] - mn);
                            ls += (p0 + p1) + (p2 + p3); pk[mt][nt][0] = pk2(p0, p1); pk[mt][nt][1] = pk2(p2, p3); }
                        else { pk[mt][nt][0] = 0u; pk[mt][nt][1] = 0u; }
                    }
                    lrow[mt] = lrow[mt] * alpha + ls;
                    if (resc) {
#pragma unroll
                        for (int dt = 0; dt < 8; ++dt) Oa[mt][dt] = Oa[mt][dt] * alpha; }
                }
                __builtin_amdgcn_sched_barrier(0);
#pragma unroll
                for (int kk = 0; kk < 2; ++kk) {
                    const int ta = 2 * kk, tb = 2 * kk + 1;
                    const bf16x8 Bp0 = as_bf16x8((u32x4){pk[0][ta][0], pk[0][ta][1], pk[0][tb][0], pk[0][tb][1]}), Bp1 = as_bf16x8((u32x4){pk[1][ta][0], pk[1][ta][1], pk[1][tb][0], pk[1][tb][1]});
#pragma unroll
                    for (int dt = 0; dt < 8; ++dt) {
                        const u32x2 va = *(const u32x2*)(vt + (dt * 16 + fr) * 72 + 16 * ta + fq * 4), vb = *(const u32x2*)(vt + (dt * 16 + fr) * 72 + 16 * tb + fq * 4);
                        const bf16x8 Av = as_bf16x8((u32x4){va.x, va.y, vb.x, vb.y});
                        Oa[0][dt] = __builtin_amdgcn_mfma_f32_16x16x32_bf16(Av, Bp0, Oa[0][dt], 0, 0, 0);
                        Oa[1][dt] = __builtin_amdgcn_mfma_f32_16x16x32_bf16(Av, Bp1, Oa[1][dt], 0, 0, 0); }
                    __builtin_amdgcn_sched_group_barrier(0x100, 8, 0);
#pragma unroll
                    for (int q = 0; q < 4; ++q) { __builtin_amdgcn_sched_group_barrier(0x008, 2, 0); __builtin_amdgcn_sched_group_barrier(0x100, 2, 0); }
                    __builtin_amdgcn_sched_group_barrier(0x008, 8, 0);
                    __builtin_amdgcn_sched_barrier(0);
                }
            }
            __syncthreads();
        }
        { bf16_t* ost = KtB + w * (32 * 136);
#pragma unroll
          for (int mt = 0; mt < 2; ++mt) {
            float l = lrow[mt]; l += __shfl_xor(l, 16); l += __shfl_xor(l, 32); const float inv = 1.f / l;
#pragma unroll
            for (int dt = 0; dt < 8; ++dt) *(u32x2*)(ost + (mt * 16 + fr) * 136 + dt * 16 + fq * 4) = (u32x2){pk2(Oa[mt][dt][0] * inv, Oa[mt][dt][1] * inv), pk2(Oa[mt][dt][2] * inv, Oa[mt][dt][3] * inv)}; }
          asm volatile("s_waitcnt lgkmcnt(0)" ::: "memory");
          const int q = lane >> 1, hf = lane & 1;
          bf16_t* op = O + (size_t)(b * SEQ + qr * 64 + qc0 + q) * D + h * 128 + hf * 64;
#pragma unroll
          for (int e = 0; e < 8; ++e) *(u32x4*)(op + e * 8) = *(const u32x4*)(ost + q * 136 + hf * 64 + e * 8); }
#undef NA_LOAD
#undef NA_WRITE
    }
    __syncthreads();
}

__device__ __forceinline__ void phase_final(const Params& p) {
    const int lane = threadIdx.x & 63, gw = blockIdx.x * 8 + (threadIdx.x >> 6), NGW = gridDim.x * 8;
    for (int m = gw; m < MLAT; m += NGW) {
        float* xr = p.out + (size_t)m * D;
        f32x4 v[8]; float ss = 0.f;
#pragma unroll
        for (int j = 0; j < 8; ++j) { v[j] = *(const f32x4*)(xr + 256 * j + 4 * lane); ss += (v[j].x * v[j].x + v[j].y * v[j].y) + (v[j].z * v[j].z + v[j].w * v[j].w); }
        f32x4 gg[8];
#pragma unroll
        for (int j = 0; j < 8; ++j) gg[j] = *(const f32x4*)(p.fin_g + 256 * j + 4 * lane);
        const float rstd = rsqrtf(wave_sum(ss) * (1.f / D) + EPS);
#pragma unroll
        for (int j = 0; j < 8; ++j) *(f32x4*)(xr + 256 * j + 4 * lane) = v[j] * rstd * gg[j];
    }
}

#define XB_TMO      128
#define XB_XCNT(j)  (256  + 64 * (j))
#define XB_XSUB(j)  (1280 + 64 * (j))
#define XB_XGEN(j)  (2304 + 64 * (j))
#define XB_TOP      3328
#define XB_TOPGEN   3392
#define XCD_BAR_WORDS 3456
#define XB_SPIN_CAP (1u << 18)
__device__ __forceinline__ unsigned xb_ld(unsigned* p)              { return __hip_atomic_load(p, __ATOMIC_RELAXED, __HIP_MEMORY_SCOPE_AGENT); }
__device__ __forceinline__ unsigned xb_add(unsigned* p, unsigned v) { return __hip_atomic_fetch_add(p, v, __ATOMIC_RELAXED, __HIP_MEMORY_SCOPE_AGENT); }
__device__ __forceinline__ unsigned xb_xcc_id() { return (unsigned)__builtin_amdgcn_s_getreg((3 << 11) | 20) & 0xFu; }
#define XB_SPIN(cond, bar) do { unsigned _sp = 0; while (cond) { __builtin_amdgcn_s_sleep(1); \
    if ((++_sp & 255u) == 0u) { if (xb_ld(&(bar)[XB_TMO])) break; if (_sp > XB_SPIN_CAP) { atomicAdd(&(bar)[XB_TMO], 1u); break; } } } } while (0)
struct XcdBarrier { unsigned* bar; unsigned x; volatile LAS unsigned* st; };
__device__ __forceinline__ XcdBarrier xcd_barrier_post(unsigned* bar, volatile LAS unsigned* st) {
    XcdBarrier b; b.bar = bar; b.x = xb_xcc_id(); b.st = st;
    if (threadIdx.x == 0) (void)xb_add(&bar[XB_XCNT(b.x)], 1u);
    return b;
}
__device__ __forceinline__ void xcd_barrier_complete(unsigned* bar, unsigned x, unsigned& nloc, unsigned& nx) {
    const unsigned G = gridDim.x * gridDim.y * gridDim.z;
    unsigned sum, cnt, mine, sp = 0u;
    for (;;) {
        sum = 0u; cnt = 0u; mine = 0u;
#pragma unroll
        for (unsigned j = 0; j < 16; ++j) { const unsigned c = xb_ld(&bar[XB_XCNT(j)]); sum += c; cnt += (c > 0u) ? 1u : 0u; mine = (j == x) ? c : mine; }
        if (sum == G) break;
        __builtin_amdgcn_s_sleep(1);
        if ((++sp & 255u) == 0u) { if (xb_ld(&bar[XB_TMO])) break; if (sp > XB_SPIN_CAP) { atomicAdd(&bar[XB_TMO], 1u); break; } }
    }
    nloc = mine > 0u ? mine : 1u; nx = cnt > 0u ? cnt : 1u;
}
__device__ __forceinline__ void xcd_barrier(const XcdBarrier& b) {
    asm volatile("s_waitcnt vmcnt(0)" ::: "memory");
    __syncthreads();
    if (threadIdx.x == 0) {
        unsigned* bar = b.bar;
        __builtin_amdgcn_s_waitcnt(0);
        unsigned nloc = b.st[0], nx = b.st[1];
        if (nloc == 0u) { xcd_barrier_complete(bar, b.x, nloc, nx); b.st[0] = nloc; b.st[1] = nx; }
        const unsigned old = xb_add(&bar[XB_XSUB(b.x)], 1u);
        const unsigned gen = old / nloc;
        if (old + 1u == (gen + 1u) * nloc) {
            __builtin_amdgcn_fence(__ATOMIC_RELEASE, "agent");
            asm volatile("s_waitcnt vmcnt(0)" ::: "memory");
            const unsigned og = xb_add(&bar[XB_TOP], 1u);
            const unsigned tg = og / nx;
            if (og + 1u == (tg + 1u) * nx) xb_add(&bar[XB_TOPGEN], 1u);
            else XB_SPIN(xb_ld(&bar[XB_TOPGEN]) == tg, bar);
            __builtin_amdgcn_fence(__ATOMIC_ACQUIRE, "agent");
            xb_add(&bar[XB_XGEN(b.x)], 1u);
            asm volatile("s_waitcnt vmcnt(0)" ::: "memory");
        } else {
            XB_SPIN(xb_ld(&bar[XB_XGEN(b.x)]) == gen, bar);
            __builtin_amdgcn_fence(__ATOMIC_ACQUIRE, "agent");
            asm volatile("s_waitcnt vmcnt(0)" ::: "memory");
        }
    }
    __syncthreads();
}

constexpr int N_PHASES = 17;
#ifndef ONLYP
#define ONLYP -1
#endif
#define PH(k) (ONLYP < 0 || ONLYP == (k))
#ifndef REPP
#define REPP -1
#endif
#define NREP(k) ((REPP == (k)) ? 2 : 1)
__device__ __forceinline__ void run_gemm_store(const Params& p, LAS unsigned char* ldsl, const int ph) {
    unsigned char* ws = p.ws; const int l1 = ph >= 9; const int Mrows = ph >= 12 ? MLAT : MALL;
    const bf16_t* A = (const bf16_t*)(ws + WS_A);
    pg8::Gemm g{D}; pg8::SegOrder S; S.init(D, gridDim.x, blockIdx.x);
    pg8::EpiBf16 E{(bf16_t*)(ws + WS_P), NIN, (bf16_t*)(ws + WS_VT), MALL, 0};
    if (ph == 2) { S.add(A, ws + WS_WIN, MALL / 256, NIN / 256, 1, D / 64, 0); S.add(ws + WS_WV0, A, 1024 / 256, MALL / 256, 1, D / 64, 1); }
    else if (ph == 10) { E.ldc0 = NQK; S.add(A, ws + WS_WQKV, MALL / 256, NQK / 256, 1, D / 64, 0); S.add((const bf16_t*)(ws + WS_WQKV) + (size_t)NQK * D, A, D / 256, MALL / 256, 1, D / 64, 1); }
    else { E.O0 = (bf16_t*)(ws + WS_H); E.ldc0 = DFF; E.ACT = 1; S.add(A, (const bf16_t*)(ws + WS_WUP) + (size_t)l1 * D * DFF, Mrows / 256, DFF / 256, 1, D / 64, 0); }
    pg8::gemm_phase<pg8::EpiBf16, pg8::SegOrder, true, true>(ldsl, g, S, E);
}
__device__ __forceinline__ void run_gemm_resid(const Params& p, LAS unsigned char* ldsl, const int ph) {
    unsigned char* ws = p.ws; const int l1 = ph >= 9;
    const float* modl = (const float*)(ws + WS_MODV) + (size_t)l1 * 5 * (6 * D);
    float* xcb = (float*)(ws + WS_XC);
    const bool dn = (ph == 8 || ph == 15);
    const int K = dn ? DFF : D;
    const bf16_t* A = dn ? (const bf16_t*)(ws + WS_H) : (const bf16_t*)(ws + WS_A);
    const bf16_t* Bt = dn ? (const bf16_t*)(ws + WS_WDN) + (size_t)l1 * D * DFF : (ph == 5 ? (const bf16_t*)(ws + WS_WOUT) : (const bf16_t*)(ws + WS_WNO));
    pg8::Gemm g{K}; pg8::SegOrder S; S.init(K, gridDim.x, blockIdx.x);
    S.add(A, Bt, MLAT / 256, D / 256, 1, K / 64, 0);
    if (!l1) S.add(A + (size_t)MLAT * K, Bt, MCTX / 256, D / 256, 8, K / 64 / 8, 1);
    pg8::EpiResid E{ph == 5 ? p.x : p.out, p.out, (float*)(ws + WS_PART), modl + (dn ? 5 : 2) * D};
    pg8::gemm_phase<pg8::EpiResid, pg8::SegOrder, true, true>(ldsl, g, S, E);
}
__global__ void __launch_bounds__(512, 2) fwd_megakernel(Params p) {
    extern __shared__ __attribute__((aligned(16))) unsigned char lds[];
    cg::grid_group grid = cg::this_grid();
    LAS unsigned char* ldsl = (LAS unsigned char*)lds;
    const int lo = p.ph_lo, hi = p.ph_hi;
    float* xcb = (float*)(p.ws + WS_XC);
#define IN(k) (lo <= (k) && (k) < hi)
    if (threadIdx.x < 2) ((volatile LAS unsigned*)(ldsl + LDS_BYTES - 64))[threadIdx.x] = 0u;
    __syncthreads();
    const XcdBarrier xb = xcd_barrier_post((unsigned*)(p.ws + WS_BAR), (volatile LAS unsigned*)(ldsl + LDS_BYTES - 64));
    if (p.ph_hi > 1000) grid.sync();
#define GSYNC() xcd_barrier(xb)
#define SEAM(k) do { if (IN(k) && IN((k) + 1)) GSYNC(); } while (0)
    if (IN(0)) { for (int rep_ = 0; rep_ < NREP(0); ++rep_) { if (rep_) GSYNC(); if (PH(0)) phase_mod(p, lds, 0, 0, gridDim.x); } } SEAM(0);
    if (IN(1)) { for (int rep_ = 0; rep_ < NREP(1); ++rep_) { if (rep_) GSYNC(); if (PH(1)) { phase_convert(p, lds, 0, 0, gridDim.x); phase_modulate(p, p.x, p.ctx, p.norm1_g, 0, 0, MALL, -1, 0); } } } SEAM(1);
    if (IN(2)) { for (int rep_ = 0; rep_ < NREP(2); ++rep_) { if (rep_) GSYNC(); if (PH(2)) run_gemm_store(p, ldsl, 2); } } SEAM(2);
    if (IN(3)) { for (int rep_ = 0; rep_ < NREP(3); ++rep_) { if (rep_) GSYNC(); if (PH(3)) { gla_pre(p, lds); lru_pre(p, lds); GSYNC(); for (int role = blockIdx.x; role < 256; role += gridDim.x) { if (role < 128) gla_seq(p, lds, role); else lru_apply(p, role - 128); }
        { const int wb0 = gridDim.x >= 256 ? 128 : 0, nwb = gridDim.x - wb0; if ((int)blockIdx.x >= wb0) { phase_convert(p, lds, 1, wb0, nwb); phase_mod(p, lds, 1, wb0, nwb); } } } } } SEAM(3);
    if (IN(4)) { for (int rep_ = 0; rep_ < NREP(4); ++rep_) { if (rep_) GSYNC(); if (PH(4)) phase_merge(p); } } SEAM(4);
    if (IN(5)) { for (int rep_ = 0; rep_ < NREP(5); ++rep_) { if (rep_) GSYNC(); if (PH(5)) run_gemm_resid(p, ldsl, 5); } } SEAM(5);
    if (IN(6)) { for (int rep_ = 0; rep_ < NREP(6); ++rep_) { if (rep_) GSYNC(); if (PH(6)) phase_modulate(p, p.out, p.ctx, p.norm2_g, 0, 1, MALL, 2, 0); } } SEAM(6);
    if (IN(7)) { for (int rep_ = 0; rep_ < NREP(7); ++rep_) { if (rep_) GSYNC(); if (PH(7)) run_gemm_store(p, ldsl, 7); } } SEAM(7);
    if (IN(8)) { for (int rep_ = 0; rep_ < NREP(8); ++rep_) { if (rep_) GSYNC(); if (PH(8)) run_gemm_resid(p, ldsl, 8); } } SEAM(8);
    if (IN(9)) { for (int rep_ = 0; rep_ < NREP(9); ++rep_) { if (rep_) GSYNC(); if (PH(9)) phase_modulate(p, p.out, xcb, p.norm1_g + D, 1, 0, MALL, 5, 0); } } SEAM(9);
    if (IN(10)) { for (int rep_ = 0; rep_ < NREP(10); ++rep_) { if (rep_) GSYNC(); if (PH(10)) run_gemm_store(p, ldsl, 10); } } SEAM(10);
    if (IN(11)) { for (int rep_ = 0; rep_ < NREP(11); ++rep_) { if (rep_) GSYNC(); if (PH(11)) phase_na(p, lds); } } SEAM(11);
    if (IN(12)) { for (int rep_ = 0; rep_ < NREP(12); ++rep_) { if (rep_) GSYNC(); if (PH(12)) run_gemm_resid(p, ldsl, 12); } } SEAM(12);
    if (IN(13)) { for (int rep_ = 0; rep_ < NREP(13); ++rep_) { if (rep_) GSYNC(); if (PH(13)) phase_modulate(p, p.out, xcb, p.norm2_g + D, 1, 1, MLAT, -1, 0); } } SEAM(13);
    if (IN(14)) { for (int rep_ = 0; rep_ < NREP(14); ++rep_) { if (rep_) GSYNC(); if (PH(14)) run_gemm_store(p, ldsl, 14); } } SEAM(14);
    if (IN(15)) { for (int rep_ = 0; rep_ < NREP(15); ++rep_) { if (rep_) GSYNC(); if (PH(15)) run_gemm_resid(p, ldsl, 15); } } SEAM(15);
    if (IN(16)) { for (int rep_ = 0; rep_ < NREP(16); ++rep_) { if (rep_) GSYNC(); if (PH(16)) phase_final(p); } }
#undef IN
#undef SEAM
}

extern "C" void kernel_launch(void* const* d_in, const int* in_sizes, int n_in, void* d_out, int out_size, void* d_ws, size_t ws_size, hipStream_t stream) {
    static int grid = 0;
    if (grid == 0) {
        if (n_in != 26 || out_size != MLAT * D || ws_size < WS_END) { fprintf(stderr, "kernel_launch: unexpected shapes (n_in %d out %d ws %zu)\n", n_in, out_size, ws_size); grid = -1; return; }
        int dev = 0, cus = 0, per_cu = 0;
        hipGetDevice(&dev); hipDeviceGetAttribute(&cus, hipDeviceAttributeMultiprocessorCount, dev);
        hipFuncSetAttribute((const void*)fwd_megakernel, hipFuncAttributeMaxDynamicSharedMemorySize, LDS_BYTES);
        hipOccupancyMaxActiveBlocksPerMultiprocessor(&per_cu, (const void*)fwd_megakernel, 512, LDS_BYTES);
        if (per_cu < 1) { fprintf(stderr, "kernel_launch: occupancy query returned %d\n", per_cu); per_cu = 1; }
        grid = cus * 1;
        (void)hipGetLastError();
    }
    if (grid < 0) return;
    if (hipMemsetAsync((char*)d_ws + WS_BAR, 0, 16384, stream) != hipSuccess) { fprintf(stderr, "kernel_launch: memset of the barrier words failed\n"); return; }
    Params p{};
    const float** f = (const float**)&p;
    for (int i = 0; i < 26; ++i) f[i] = (const float*)d_in[i];
    p.out = (float*)d_out; p.ws = (unsigned char*)d_ws; p.ph_lo = 0; p.ph_hi = N_PHASES;
    void* args[] = {&p};
    hipError_t e = hipLaunchCooperativeKernel((const void*)fwd_megakernel, dim3(grid), dim3(512), args, LDS_BYTES, stream);
    if (e != hipSuccess) fprintf(stderr, "cooperative launch failed: %s (grid %d)\n", hipGetErrorString(e), grid);
}
```

```cpp
#include <hip/hip_runtime.h>
#include <hip/hip_cooperative_groups.h>
#include <cstdio>
#include <cstdint>
namespace cg = cooperative_groups;

#define LAS __attribute__((address_space(3)))
typedef unsigned short bf16_t;
typedef short bf16x8 __attribute__((ext_vector_type(8)));
typedef float f32x4 __attribute__((ext_vector_type(4)));
typedef float f32x2 __attribute__((ext_vector_type(2)));
typedef unsigned u32x4 __attribute__((ext_vector_type(4)));
typedef unsigned u32x2 __attribute__((ext_vector_type(2)));

constexpr int D = 2048, NB = 4, SEQ = 4096, CTX = 256, DFF = 8192;
constexpr int MLAT = NB * SEQ, MCTX = NB * CTX, MALL = MLAT + MCTX;
constexpr int NIN = 4352;
constexpr int C_Q = 0, C_K = 512, C_OG = 1024, C_XR = 2048, C_YR = 3072, C_GL = 4096;
constexpr int NQKV = 6144, NQK = 4096;
constexpr float EPS = 1e-6f;

constexpr size_t MiB = 1u << 20;
constexpr size_t WS_MODV = 0;
constexpr size_t WS_BAR = 544 * 1024;
constexpr size_t WS_ROPE = 512 * 1024;
constexpr size_t WS_WIN = 1 * MiB;
constexpr size_t WS_WV0 = 18 * MiB;
constexpr size_t WS_WOUT = 22 * MiB;
constexpr size_t WS_WUP = 30 * MiB;
constexpr size_t WS_WDN = 94 * MiB;
constexpr size_t WS_WQKV = 158 * MiB;
constexpr size_t WS_WNO = 182 * MiB;
constexpr size_t WS_XC = 190 * MiB;
constexpr size_t WS_A = 198 * MiB;
constexpr size_t WS_R = 266 * MiB;
constexpr size_t WS_P = WS_R;
constexpr size_t WS_VT = WS_R + 146 * MiB;
constexpr size_t WS_OF = WS_R + 214 * MiB;
constexpr size_t WS_OB = WS_R + 282 * MiB;
constexpr size_t WS_HF = WS_R + 350 * MiB;
constexpr size_t WS_HB = WS_R + 384 * MiB;
constexpr size_t WS_GQ = WS_A, WS_GK = WS_A + 34 * MiB;
constexpr size_t WS_GATT = WS_R + 418 * MiB, WS_GBLE = WS_R + 435 * MiB;
constexpr size_t WS_PART = WS_R + 300 * MiB;
constexpr size_t WS_H = WS_R;
constexpr size_t WS_LRUW = WS_R + 437 * MiB;
constexpr size_t WS_END = WS_R + 439 * MiB;

constexpr int LDS_BYTES = 147456;

struct Params {
    const float *x, *c, *ctx, *c_ctx, *mod_w, *mod_b, *norm1_g, *norm2_g, *mlp_up, *mlp_down, *ev_w_in, *ev_w_out;
    const float *gate_up, *gate_b, *gla_g, *conv_w, *conv_b, *w_a, *b_a, *w_x, *b_x, *lam, *na_qkv, *na_out, *rel_bias, *fin_g;
    float* out; unsigned char* ws;
    int ph_lo, ph_hi;
};

typedef __bf16 hwbf16x2 __attribute__((ext_vector_type(2)));
__device__ __forceinline__ unsigned f2bf(float f) { return (unsigned)__builtin_bit_cast(unsigned short, (__bf16)f); }
__device__ __forceinline__ unsigned pk2(float lo, float hi) { return __builtin_bit_cast(unsigned, __builtin_convertvector((f32x2){lo, hi}, hwbf16x2)); }
__device__ __forceinline__ float bflo(unsigned w) { return __builtin_bit_cast(float, w << 16); }
__device__ __forceinline__ float bfhi(unsigned w) { return __builtin_bit_cast(float, w & 0xffff0000u); }
__device__ __forceinline__ float bf1(bf16_t v) { return __builtin_bit_cast(float, (unsigned)v << 16); }
__device__ __forceinline__ float wave_sum(float v) {
#pragma unroll
    for (int o = 1; o < 64; o <<= 1) v += __shfl_xor(v, o);
    return v;
}
__device__ __forceinline__ float dpp_ror(float v, const int ctrl) { return v; }
#define ROW_ROR(v, n) __builtin_bit_cast(float, __builtin_amdgcn_update_dpp(0, __builtin_bit_cast(int, (v)), 0x120 + (n), 0xf, 0xf, false))
__device__ __forceinline__ float row16_max(float v) { v = fmaxf(v, ROW_ROR(v, 8)); v = fmaxf(v, ROW_ROR(v, 4)); v = fmaxf(v, ROW_ROR(v, 2)); v = fmaxf(v, ROW_ROR(v, 1)); return v; }
__device__ __forceinline__ float row16_sum(float v) { v += ROW_ROR(v, 8); v += ROW_ROR(v, 4); v += ROW_ROR(v, 2); v += ROW_ROR(v, 1); return v; }
__device__ __forceinline__ float sigmoidf_(float x) { return 1.f / (1.f + __expf(-x)); }
__device__ __forceinline__ float logsigf_(float z) { return fminf(z, 0.f) - __logf(1.f + __expf(-fabsf(z))); }
__device__ __forceinline__ float siluf_(float x) { return x / (1.f + __expf(-x)); }
__device__ __forceinline__ float gelu_tanh(float x) {
    const float u = 0.7978845608028654f * (x + 0.044715f * x * x * x);
    const float t = 1.f - 2.f / (1.f + __expf(2.f * u));
    return 0.5f * x * (1.f + t);
}
__device__ __forceinline__ void unpack8(u32x4 w, float* f) {
    f[0] = bflo(w.x); f[1] = bfhi(w.x); f[2] = bflo(w.y); f[3] = bfhi(w.y); f[4] = bflo(w.z); f[5] = bfhi(w.z); f[6] = bflo(w.w); f[7] = bfhi(w.w);
}
__device__ __forceinline__ bf16x8 as_bf16x8(u32x4 w) { return __builtin_bit_cast(bf16x8, w); }

namespace pg8 {
constexpr int BM = 256, BK = 64, HALF = 128, HTB = HALF * BK * 2, STAGE_BYTES = 8 * HTB, NXCD = 8, WGM = 4;
__host__ __device__ __forceinline__ int lds_byte(int r, int c) { const int st = (r >> 4) * 2 + (c >> 5), rr = r & 15, cc = c & 31, ob = rr * 64 + cc * 2; return st * 1024 + (ob ^ (((ob >> 9) & 1) << 5)); }
__host__ __device__ __forceinline__ void stage_rc(int b, int& R, int& C) { const int st = b / 1024, sb = b % 1024, swz = sb ^ (((sb >> 9) & 1) << 5); R = (st >> 1) * 16 + swz / 64; C = (st & 1) * 32 + (swz % 64) / 2; }
__host__ __device__ __forceinline__ int perm32(int rho) { const int n = rho >> 4, i = rho & 15; return 8 * (i >> 2) + 4 * n + (i & 3); }
struct Unit { const char* a; const char* b; int nt, pm, pn, mode, ksi; };
struct Gemm { int ld; };
struct Seg { const char* a; const char* b; int nM, nN, ks, nt, mode, count; };
struct SegOrder {
    Seg s0, s1; int nseg, G, c; size_t tstep;
    __device__ __forceinline__ void init(int ld, int G_, int c_) { G = G_; c = c_; tstep = (size_t)BM * ld * 2; nseg = 0; s1.count = 0; }
    __device__ __forceinline__ void add(const void* a, const void* b, int nM, int nN, int ks, int nt, int mode) {
        Seg q; q.a = (const char*)a; q.b = (const char*)b; q.nM = nM; q.nN = nN; q.ks = ks; q.nt = nt; q.mode = mode; q.count = nM * nN * ks;
        if (nseg == 0) s0 = q; else s1 = q; ++nseg; }
    __device__ __forceinline__ bool next(int i, Unit& u) const {
        long L = (long)i * G + c; bool second = false;
        if (L >= s0.count) { L -= s0.count; second = true; if (L >= s1.count) return false; }
        const char* qa = second ? s1.a : s0.a; const char* qb = second ? s1.b : s0.b;
        const int nM = second ? s1.nM : s0.nM, nN = second ? s1.nN : s0.nN, ks = second ? s1.ks : s0.ks, qnt = second ? s1.nt : s0.nt, mode = second ? s1.mode : s0.mode;
        const int ksi = (int)(L % ks); int wgid = (int)(L / ks); const int nwg = nM * nN;
        { const int qq = nwg / NXCD, r = nwg % NXCD, xcd = wgid % NXCD, off = wgid / NXCD; wgid = (xcd < r ? xcd * (qq + 1) : r * (qq + 1) + (xcd - r) * qq) + off; }
        const int nig = WGM * nN, gid = wgid / nig, fm = gid * WGM, gsz = (nM - fm) < WGM ? (nM - fm) : WGM;
        u.pm = fm + ((wgid % nig) % gsz); u.pn = (wgid % nig) / gsz; u.nt = qnt; u.mode = mode; u.ksi = ksi;
        const size_t koff = (size_t)ksi * qnt * (BK * 2);
        u.a = qa + (size_t)u.pm * tstep + koff; u.b = qb + (size_t)u.pn * tstep + koff; return true;
    }
    __device__ __forceinline__ void a_ready(const Unit&) const {}
    __device__ __forceinline__ void done(const Unit&) const {}
};
__device__ __forceinline__ unsigned cvt_pk_bf16(float lo, float hi) { return pk2(lo, hi); }

struct EpiBf16 {
    static constexpr bool PERM = true, AFTER_DRAIN = false;
    bf16_t* O0; int ldc0; bf16_t* O1; int ldc1; int ACT;
    __device__ __forceinline__ void operator()(const f32x4 (&acc)[2][2][4][2], const Unit& u, int wr, int wc, int fr, int fq) const {
        const int row0 = u.pm * BM + wr * 64 + fr; const int col0 = u.pn * BM + wc * 32 + 8 * fq;
        bf16_t* O = u.mode ? O1 : O0; const int ldc = u.mode ? ldc1 : ldc0;
#pragma unroll
        for (int ai = 0; ai < 2; ++ai)
#pragma unroll
            for (int m = 0; m < 4; ++m) { bf16_t* rowp = O + (size_t)(row0 + ai * HALF + m * 16) * ldc + col0;
#pragma unroll
                for (int bj = 0; bj < 2; ++bj) { f32x4 v0 = acc[ai][bj][m][0], v1 = acc[ai][bj][m][1];
                    if (ACT == 1) {
#pragma unroll
                        for (int e = 0; e < 4; ++e) { float a = fmaxf(v0[e], 0.f), b = fmaxf(v1[e], 0.f); v0[e] = a * a; v1[e] = b * b; } }
                    u32x4 w; w.x = cvt_pk_bf16(v0[0], v0[1]); w.y = cvt_pk_bf16(v0[2], v0[3]); w.z = cvt_pk_bf16(v1[0], v1[1]); w.w = cvt_pk_bf16(v1[2], v1[3]);
                    *(u32x4*)(rowp + bj * HALF) = w; } }
    }
};
struct EpiResid {
    static constexpr bool PERM = false, AFTER_DRAIN = false;
    const float* base_lat; float* out_lat; float* out_ctx; const float* gate;
    __device__ __forceinline__ void operator()(const f32x4 (&acc)[2][2][4][2], const Unit& u, int wr, int wc, int fr, int fq) const {
        const bool isl = u.mode == 0;
        const int bidx = isl ? (u.pm >> 4) : 4;
        const float* gp = gate + (size_t)bidx * (6 * D) + u.pn * BM + wc * 32 + 4 * fq;
        const size_t eoff = ((size_t)u.pm * BM + wr * 64 + fr) * D + u.pn * BM + wc * 32 + 4 * fq;
        f32x4 gv[2][2];
#pragma unroll
        for (int bj = 0; bj < 2; ++bj)
#pragma unroll
            for (int n = 0; n < 2; ++n) gv[bj][n] = *(const f32x4*)(gp + bj * HALF + n * 16);
        if (isl) {
            const float* bp = base_lat + eoff; float* op = out_lat + eoff;
#pragma unroll
            for (int ai = 0; ai < 2; ++ai) {
                f32x4 bs[4][2][2];
#pragma unroll
                for (int m = 0; m < 4; ++m)
#pragma unroll
                    for (int bj = 0; bj < 2; ++bj)
#pragma unroll
                        for (int n = 0; n < 2; ++n) bs[m][bj][n] = *(const f32x4*)(bp + (size_t)(ai * HALF + m * 16) * D + bj * HALF + n * 16);
                asm volatile("" ::: "memory");
#pragma unroll
                for (int m = 0; m < 4; ++m)
#pragma unroll
                    for (int bj = 0; bj < 2; ++bj)
#pragma unroll
                        for (int n = 0; n < 2; ++n) *(f32x4*)(op + (size_t)(ai * HALF + m * 16) * D + bj * HALF + n * 16) = bs[m][bj][n] + gv[bj][n] * acc[ai][bj][m][n];
                asm volatile("" ::: "memory");
            }
        } else {
            float* op = out_ctx + (size_t)u.ksi * MCTX * D + eoff;
#pragma unroll
            for (int ai = 0; ai < 2; ++ai)
#pragma unroll
                for (int m = 0; m < 4; ++m) { const size_t off = (size_t)(ai * HALF + m * 16) * D;
#pragma unroll
                    for (int bj = 0; bj < 2; ++bj)
#pragma unroll
                        for (int n = 0; n < 2; ++n) *(f32x4*)(op + off + bj * HALF + n * 16) = acc[ai][bj][m][n]; }
        }
    }
};

template <class Epi, class Sched, bool ALIGN_EPI = false, bool SP2 = false>
__device__ __forceinline__ void gemm_phase(LAS unsigned char* lds, const Gemm g, const Sched& S, const Epi& E) {
    const int tid = threadIdx.x, wid = __builtin_amdgcn_readfirstlane(tid >> 6), lane = tid & 63, wr = wid >> 2, wc = wid & 3, fr = lane & 15, fq = lane >> 4;
    const int K = g.ld;
    unsigned voffA[2], voffB[2];
#pragma unroll
    for (int i = 0; i < 2; ++i) { int R, C; stage_rc(tid * 16 + i * 8192, R, C); const int Rb = Epi::PERM ? ((R & ~31) + perm32(R & 31)) : R;
        voffA[i] = (unsigned)(R * K + C) * 2u; voffB[i] = (unsigned)(Rb * K + C) * 2u; }
    const size_t kstep = (size_t)(BK * 2);
    const size_t hstep = (size_t)HALF * K * 2;
    const unsigned ldsw = (unsigned)wid * 1024u;
    const int aoff = lds_byte(wr * 64 + fr, fq * 8), boff = lds_byte(wc * 32 + fr, fq * 8);
#define PG8_SA(b, h) (((b) * 2 + (h)) * HTB)
#define PG8_SB(b, h) ((4 + (b) * 2 + (h)) * HTB)
#define PG8_STAGE(bufoff, gbase, voff) do { _Pragma("unroll") for (int _i = 0; _i < 2; ++_i) \
        __builtin_amdgcn_global_load_lds((const unsigned*)((const char*)(gbase) + (voff)[_i]), (LAS unsigned*)(lds + (bufoff) + ldsw + _i * 8192), 16, 0, 0); } while (0)
#define PG8_LDA(dst, b, h) do { _Pragma("unroll") for (int m = 0; m < 4; ++m) _Pragma("unroll") for (int k = 0; k < 2; ++k) dst[m][k] = *(const LAS bf16x8*)(lds + PG8_SA(b, h) + aoff + m * 2048 + k * 1024); } while (0)
#define PG8_LDB(dst, b, h) do { _Pragma("unroll") for (int n = 0; n < 2; ++n) _Pragma("unroll") for (int k = 0; k < 2; ++k) dst[n][k] = *(const LAS bf16x8*)(lds + PG8_SB(b, h) + boff + n * 2048 + k * 1024); } while (0)
#define PG8_MMA(ai, bj, At, Bt) do { __builtin_amdgcn_s_setprio(1); _Pragma("unroll") for (int m = 0; m < 4; ++m) _Pragma("unroll") for (int n = 0; n < 2; ++n) _Pragma("unroll") for (int k = 0; k < 2; ++k) \
        acc[ai][bj][m][n] = __builtin_amdgcn_mfma_f32_16x16x32_bf16(Bt[n][k], At[m][k], acc[ai][bj][m][n], 0, 0, 0); __builtin_amdgcn_s_setprio(0); } while (0)
#define PG8_WAIT_V(n) asm volatile("s_waitcnt vmcnt(" #n ")" ::: "memory")
#define PG8_WAIT_L(n) asm volatile("s_waitcnt lgkmcnt(" #n ")" ::: "memory")
#define PG8_BAR __builtin_amdgcn_s_barrier()
#define PG8_SCHED __builtin_amdgcn_sched_barrier(0)
    Unit cur, nxt; int ui = 0;
    if (!S.next(0, cur)) return;
    f32x4 acc[2][2][4][2];
#pragma unroll
    for (int a = 0; a < 2; ++a)
#pragma unroll
        for (int b = 0; b < 2; ++b)
#pragma unroll
            for (int m = 0; m < 4; ++m)
#pragma unroll
                for (int n = 0; n < 2; ++n) acc[a][b][m][n] = (f32x4){0.f, 0.f, 0.f, 0.f};
    bf16x8 At[4][2], B0[2][2], B1[2][2];
    const char* cA = cur.a; const char* cB = cur.b;
    S.a_ready(cur);
    if constexpr (SP2) {
        PG8_STAGE(PG8_SB(0, 0), cB, voffB); PG8_STAGE(PG8_SB(0, 1), cB + hstep, voffB); PG8_STAGE(PG8_SA(0, 0), cA, voffA); PG8_STAGE(PG8_SA(0, 1), cA + hstep, voffA);
        if (wr == 1) PG8_BAR;
        PG8_WAIT_V(2); PG8_BAR;
        PG8_STAGE(PG8_SB(1, 0), cB + kstep, voffB); PG8_STAGE(PG8_SA(1, 0), cA + kstep, voffA); PG8_STAGE(PG8_SB(1, 1), cB + hstep + kstep, voffB);
        PG8_WAIT_V(6); PG8_BAR;
    } else {
        PG8_STAGE(PG8_SB(0, 0), cB, voffB); PG8_STAGE(PG8_SA(0, 0), cA, voffA); PG8_STAGE(PG8_SB(0, 1), cB + hstep, voffB); PG8_STAGE(PG8_SA(0, 1), cA + hstep, voffA);
        if (wr == 1) PG8_BAR;
        PG8_WAIT_V(4); PG8_BAR;
        PG8_STAGE(PG8_SB(1, 0), cB + kstep, voffB); PG8_STAGE(PG8_SA(1, 0), cA + kstep, voffA); PG8_STAGE(PG8_SB(1, 1), cB + hstep + kstep, voffB);
        PG8_WAIT_V(6); PG8_BAR;
    }
    for (;;) {
        const bool has_next = S.next(ui + 1, nxt);
        const char* nA = has_next ? nxt.a : cA; const char* nB = has_next ? nxt.b : cB;
        const int nt = cur.nt;
        for (int t = 0; t < nt; t += 2) {
            const bool last = (t == nt - 2);
            const char* a1 = cA + (size_t)(t + 1) * kstep;
            const char* a2 = last ? nA : cA + (size_t)(t + 2) * kstep; const char* b2 = last ? nB : cB + (size_t)(t + 2) * kstep;
            const char* a3 = a2 + kstep; const char* b3 = b2 + kstep;
            if (last && has_next) S.a_ready(nxt);
            if constexpr (SP2) {
            PG8_LDB(B0, 0, 0); PG8_LDB(B1, 0, 1); PG8_SCHED; PG8_LDA(At, 0, 0); PG8_STAGE(PG8_SA(1, 1), a1 + hstep, voffA);
            PG8_WAIT_V(8); PG8_WAIT_L(0); PG8_BAR; PG8_MMA(0, 0, At, B0); PG8_MMA(0, 1, At, B1); PG8_BAR; PG8_SCHED;
            PG8_LDA(At, 0, 1); PG8_STAGE(PG8_SB(0, 0), b2, voffB); PG8_STAGE(PG8_SB(0, 1), b2 + hstep, voffB); PG8_STAGE(PG8_SA(0, 0), a2, voffA);
            PG8_WAIT_V(8); PG8_WAIT_L(0); PG8_BAR; PG8_MMA(1, 0, At, B0); PG8_MMA(1, 1, At, B1); PG8_BAR; PG8_SCHED;
            PG8_LDB(B0, 1, 0); PG8_LDB(B1, 1, 1); PG8_SCHED; PG8_LDA(At, 1, 0); PG8_STAGE(PG8_SA(0, 1), a2 + hstep, voffA);
            PG8_WAIT_V(8); PG8_WAIT_L(0); PG8_BAR; PG8_MMA(0, 0, At, B0); PG8_MMA(0, 1, At, B1); PG8_BAR; PG8_SCHED;
            PG8_LDA(At, 1, 1); PG8_STAGE(PG8_SB(1, 0), b3, voffB); PG8_STAGE(PG8_SB(1, 1), b3 + hstep, voffB); PG8_STAGE(PG8_SA(1, 0), a3, voffA);
            PG8_WAIT_V(8); PG8_WAIT_L(0); PG8_BAR; PG8_MMA(1, 0, At, B0); PG8_MMA(1, 1, At, B1); PG8_BAR; PG8_SCHED;
            } else {
            PG8_LDB(B0, 0, 0); PG8_SCHED; PG8_LDA(At, 0, 0); PG8_STAGE(PG8_SA(1, 1), a1 + hstep, voffA);
            PG8_WAIT_L(8); PG8_BAR; PG8_WAIT_L(0); PG8_MMA(0, 0, At, B0); PG8_BAR; PG8_SCHED;
            PG8_LDB(B1, 0, 1); PG8_STAGE(PG8_SB(0, 0), b2, voffB);
            PG8_BAR; PG8_WAIT_L(0); PG8_MMA(0, 1, At, B1); PG8_BAR;
            PG8_LDA(At, 0, 1); PG8_STAGE(PG8_SA(0, 0), a2, voffA);
            PG8_BAR; PG8_WAIT_L(0); PG8_MMA(1, 0, At, B0); PG8_BAR; PG8_SCHED;
            PG8_STAGE(PG8_SB(0, 1), b2 + hstep, voffB);
            PG8_WAIT_V(6); PG8_BAR; PG8_MMA(1, 1, At, B1); PG8_BAR;
            PG8_LDB(B0, 1, 0); PG8_SCHED; PG8_LDA(At, 1, 0); PG8_STAGE(PG8_SA(0, 1), a2 + hstep, voffA);
            PG8_WAIT_L(8); PG8_BAR; PG8_WAIT_L(0); PG8_MMA(0, 0, At, B0); PG8_BAR; PG8_SCHED;
            PG8_LDB(B1, 1, 1); PG8_STAGE(PG8_SB(1, 0), b3, voffB);
            PG8_BAR; PG8_WAIT_L(0); PG8_MMA(0, 1, At, B1); PG8_BAR;
            PG8_LDA(At, 1, 1); PG8_STAGE(PG8_SA(1, 0), a3, voffA);
            PG8_BAR; PG8_WAIT_L(0); PG8_MMA(1, 0, At, B0); PG8_BAR; PG8_SCHED;
            PG8_STAGE(PG8_SB(1, 1), b3 + hstep, voffB);
            PG8_WAIT_V(6); PG8_BAR; PG8_MMA(1, 1, At, B1); PG8_BAR;
            }
        }
        if constexpr (ALIGN_EPI) { if (wr == 0) PG8_BAR; }
        if constexpr (!Epi::AFTER_DRAIN) { E(acc, cur, wr, wc, fr, fq); S.done(cur); }
        if (!has_next) break;
#pragma unroll
        for (int a = 0; a < 2; ++a)
#pragma unroll
            for (int b = 0; b < 2; ++b)
#pragma unroll
                for (int m = 0; m < 4; ++m)
#pragma unroll
                    for (int n = 0; n < 2; ++n) acc[a][b][m][n] = (f32x4){0.f, 0.f, 0.f, 0.f};
        cur = nxt; cA = nA; cB = nB; ++ui;
        if constexpr (ALIGN_EPI) { if (wr == 1) PG8_BAR; }
    }
    PG8_WAIT_V(0);
    if constexpr (!ALIGN_EPI) { if (wr == 0) PG8_BAR; }
    PG8_BAR;
#undef PG8_SA
#undef PG8_SB
#undef PG8_STAGE
#undef PG8_LDA
#undef PG8_LDB
#undef PG8_MMA
#undef PG8_WAIT_V
#undef PG8_WAIT_L
#undef PG8_BAR
#undef PG8_SCHED
}
}

__device__ __forceinline__ void phase_mod(const Params& p, unsigned char* lds, const int layer, const int wb0, const int nwb) {
    const int tid = threadIdx.x;
    float* sc = (float*)lds;
    float* red = (float*)(lds + 40960);
    float* modv = (float*)(p.ws + WS_MODV);
    __syncthreads();
    for (int e = tid; e < 5 * D; e += 512) { const int r = e / D, k = e % D; const float v = r < 4 ? p.c[r * D + k] : p.c_ctx[k]; sc[e] = siluf_(v); }
    __syncthreads();
    for (int it = (int)blockIdx.x - wb0; it < 256; it += nwb) {
        const int l = layer, n0 = it * 48;
        const int kg = tid / 12, cg_ = tid % 12;
        float acc[5][4];
#pragma unroll
        for (int r = 0; r < 5; ++r)
#pragma unroll
            for (int j = 0; j < 4; ++j) acc[r][j] = 0.f;
        if (kg < 42) {
            const float* wp = p.mod_w + (size_t)l * D * (6 * D) + n0 + 4 * cg_;
#pragma unroll 4
            for (int k = kg; k < D; k += 42) {
                const f32x4 w = *(const f32x4*)(wp + (size_t)k * (6 * D));
#pragma unroll
                for (int r = 0; r < 5; ++r) { const float s = sc[r * D + k];
#pragma unroll
                    for (int j = 0; j < 4; ++j) acc[r][j] += s * w[j]; }
            }
#pragma unroll
            for (int r = 0; r < 5; ++r)
#pragma unroll
                for (int j = 0; j < 4; ++j) red[(kg * 5 + r) * 48 + 4 * cg_ + j] = acc[r][j];
        }
        __syncthreads();
        if (tid < 240) { const int r = tid / 48, n = tid % 48; float s = p.mod_b[l * (6 * D) + n0 + n];
            for (int q = 0; q < 42; ++q) s += red[(q * 5 + r) * 48 + n];
            modv[((size_t)l * 5 + r) * (6 * D) + n0 + n] = s; }
        __syncthreads();
    }
    if (layer == 0 && blockIdx.x == gridDim.x - 1) {
        f32x2* tab = (f32x2*)(p.ws + WS_ROPE);
        for (int e = tid; e < 64 * 32; e += 512) { const int pos = e >> 5, i = e & 31;
            const float inv = exp2f(-(float)i * (13.287712379549449f / 32.f));
            const float ang = (float)pos * inv;
            tab[e] = (f32x2){__cosf(ang), __sinf(ang)}; }
    }
}

__device__ __forceinline__ void transpose_item(const float* W, int K, int N, bf16_t* WT, int kb, int n0, int dst_n0, float* scr, int lane) {
    const int k0 = 64 * kb;
    float wv[32];
#pragma unroll
    for (int i = 0; i < 32; ++i) wv[i] = W[(size_t)(k0 + 2 * i + (lane >> 5)) * N + n0 + (lane & 31)];
#pragma unroll
    for (int i = 0; i < 32; ++i) scr[(2 * i + (lane >> 5)) * 33 + (lane & 31)] = wv[i];
    asm volatile("s_waitcnt lgkmcnt(0)" ::: "memory");
    const int c = lane & 7;
#pragma unroll
    for (int j = 0; j < 4; ++j) { const int n = (lane >> 3) + 8 * j; const float* s = scr + (8 * c) * 33 + n;
        u32x4 o; o.x = pk2(s[0 * 33], s[1 * 33]); o.y = pk2(s[2 * 33], s[3 * 33]); o.z = pk2(s[4 * 33], s[5 * 33]); o.w = pk2(s[6 * 33], s[7 * 33]);
        *(u32x4*)(WT + (size_t)(dst_n0 + n) * K + k0 + 8 * c) = o; }
    asm volatile("s_waitcnt lgkmcnt(0)" ::: "memory");
}
__device__ __forceinline__ void modulate_row(const float* xr, const float* g, const float* shift, const float* scale, bf16_t* dst, int lane, const float* part, const float* cgate, float* xw) {
    f32x4 v[8]; float ss = 0.f;
#pragma unroll
    for (int j = 0; j < 8; ++j) { const int c = 256 * j + 4 * lane; v[j] = *(const f32x4*)(xr + c);
        if (part) { f32x4 a = *(const f32x4*)(part + c);
#pragma unroll
            for (int sp = 1; sp < 8; ++sp) a += *(const f32x4*)(part + (size_t)sp * MCTX * D + c);
            v[j] += *(const f32x4*)(cgate + c) * a; *(f32x4*)(xw + c) = v[j]; }
        ss += (v[j].x * v[j].x + v[j].y * v[j].y) + (v[j].z * v[j].z + v[j].w * v[j].w); }
    const float rstd = rsqrtf(wave_sum(ss) * (1.f / D) + EPS);
#pragma unroll
    for (int j = 0; j < 8; ++j) { const int c = 256 * j + 4 * lane;
        const f32x4 gg = *(const f32x4*)(g + c), sh = *(const f32x4*)(shift + c), sc = *(const f32x4*)(scale + c);
        const f32x4 o = v[j] * rstd * gg * (sc + 1.f) + sh;
        u32x2 w; w.x = pk2(o.x, o.y); w.y = pk2(o.z, o.w); *(u32x2*)(dst + c) = w; }
}
__device__ __forceinline__ void phase_modulate(const Params& p, const float* xl, const float* xc, const float* g, int layer, int which, int nrows, int cslot, int clayer) {
    const int lane = threadIdx.x & 63, gw = blockIdx.x * 8 + (threadIdx.x >> 6), NGW = gridDim.x * 8;
    const float* modv = (const float*)(p.ws + WS_MODV) + (size_t)layer * 5 * (6 * D);
    const float* cgate = (const float*)(p.ws + WS_MODV) + ((size_t)clayer * 5 + 4) * (6 * D) + (cslot < 0 ? 0 : cslot) * D;
    bf16_t* A = (bf16_t*)(p.ws + WS_A);
    for (int m = gw; m < nrows; m += NGW) {
        const bool isl = m < MLAT; const int bidx = isl ? (m >> 12) : 4;
        const float* xr = isl ? xl + (size_t)m * D : xc + (size_t)(m - MLAT) * D;
        const float* mv = modv + (size_t)bidx * (6 * D) + which * 3 * D;
        const float* part = (!isl && cslot >= 0) ? (const float*)(p.ws + WS_PART) + (size_t)(m - MLAT) * D : nullptr;
        float* xw = (float*)(p.ws + WS_XC) + (size_t)(isl ? 0 : m - MLAT) * D;
        modulate_row(xr, g, mv, mv + D, A + (size_t)m * D, lane, part, cgate, xw);
    }
}
__device__ __forceinline__ void phase_convert(const Params& p, unsigned char* lds, const int part, const int wb0, const int nwb, const int it_lo = 0, const int it_hi = 1 << 30) {
    const int lane = threadIdx.x & 63, wave = threadIdx.x >> 6;
    float* scr = (float*)(lds + wave * 16384);
    const int gw = ((int)blockIdx.x - wb0) * 8 + wave, NGW = nwb * 8;
    constexpr int I_IN = 32 * 161, I_OUT = 32 * 64, I_UP = 32 * 256, I_DN = 128 * 64, I_QKV = 32 * 192, I_NO = 32 * 64;
    bf16_t* win = (bf16_t*)(p.ws + WS_WIN); bf16_t* wout = (bf16_t*)(p.ws + WS_WOUT); bf16_t* wup = (bf16_t*)(p.ws + WS_WUP);
    bf16_t* wdn = (bf16_t*)(p.ws + WS_WDN); bf16_t* wqkv = (bf16_t*)(p.ws + WS_WQKV); bf16_t* wno = (bf16_t*)(p.ws + WS_WNO);
    __syncthreads();
    if (part == 0) {
        for (int it = it_lo + gw; it < min(I_IN + I_OUT + I_UP + I_DN, it_hi); it += NGW) {
            int r = it;
            if (r < I_IN) { const int kb = r / 161, nb = r % 161, n0 = 32 * nb;
                if (n0 >= 1024 && n0 < 2048) { transpose_item(p.ev_w_in, D, 5152, (bf16_t*)(p.ws + WS_WV0), kb, n0, n0 - 1024, scr, lane); continue; }
                const int dn = n0 < 1024 ? n0 : (n0 < 3072 ? n0 - 1024 : (n0 == 3072 ? C_GL : (n0 < 4128 ? n0 - 3104 + C_XR : n0 - 4128 + C_YR)));
                transpose_item(p.ev_w_in, D, 5152, win, kb, n0, dn, scr, lane); continue; } r -= I_IN;
            if (r < I_OUT) { transpose_item(p.ev_w_out, D, D, wout, r / 64, 32 * (r % 64), 32 * (r % 64), scr, lane); continue; } r -= I_OUT;
            if (r < I_UP) { transpose_item(p.mlp_up, D, DFF, wup, r / 256, 32 * (r % 256), 32 * (r % 256), scr, lane); continue; } r -= I_UP;
            transpose_item(p.mlp_down, DFF, D, wdn, r / 64, 32 * (r % 64), 32 * (r % 64), scr, lane);
        }
        if (it_lo == 0) {
        for (int m = (int)blockIdx.x - wb0; m < 32; m += nwb) { const float* src = ((m & 1) ? p.w_x : p.w_a) + (size_t)(m >> 1) * 16384; bf16_t* img = (bf16_t*)(p.ws + WS_LRUW) + (size_t)m * (128 * 136);
            for (int e = threadIdx.x; e < 16384; e += 512) { const int ii = e >> 7, j = e & 127; img[j * 136 + ii] = (bf16_t)f2bf(src[e]); }
            for (int e = threadIdx.x; e < 128 * 8; e += 512) img[(e >> 3) * 136 + 128 + (e & 7)] = (bf16_t)0; }
        u32x4* z = (u32x4*)(win + (size_t)4128 * D); const int nz = (NIN - 4128) * D * 2 / 16;
        for (int e = ((int)blockIdx.x - wb0) * 512 + threadIdx.x; e < nz; e += nwb * 512) z[e] = (u32x4){0u, 0u, 0u, 0u};
        }
    } else {
        for (int it = gw; it < I_UP + I_DN + I_QKV + I_NO; it += NGW) {
            int r = it;
            if (r < I_UP) { transpose_item(p.mlp_up + (size_t)D * DFF, D, DFF, wup + (size_t)D * DFF, r / 256, 32 * (r % 256), 32 * (r % 256), scr, lane); continue; } r -= I_UP;
            if (r < I_DN) { transpose_item(p.mlp_down + (size_t)D * DFF, DFF, D, wdn + (size_t)D * DFF, r / 64, 32 * (r % 64), 32 * (r % 64), scr, lane); continue; } r -= I_DN;
            if (r < I_QKV) { transpose_item(p.na_qkv, D, NQKV, wqkv, r / 192, 32 * (r % 192), 32 * (r % 192), scr, lane); continue; } r -= I_QKV;
            transpose_item(p.na_out, D, D, wno, r / 64, 32 * (r % 64), 32 * (r % 64), scr, lane);
        }
    }
    __syncthreads();
}

constexpr int GL_GU = 0, GL_GB = 8192, GL_TAB = 8704, GL_GBUF = 25088, GL_TOT = 58880, GL_BLE = 60928, GL_QE = 61440, GL_KE = 78848, GL_VT = 96256, GL_ATT = 105472, GL_ST = 114688, GL_END = 132096;
static_assert(GL_END <= LDS_BYTES, "gla lds");
#define GLA_ROW(ci, ii, row, tok, isl) do { isl = (ci) >= 4; const int cc_ = isl ? (ci) - 4 : (ci); const int n_ = isl ? SEQ : CTX; const int pos_ = cc_ * 64 + (ii); \
        tok = dir ? n_ - 1 - pos_ : pos_; row = isl ? (size_t)b * SEQ + tok : (size_t)MLAT + b * CTX + tok; } while (0)
__device__ __forceinline__ void gla_pre(const Params& p, unsigned char* lds) {
    const int tid = threadIdx.x, lane = tid & 63, w = __builtin_amdgcn_readfirstlane(tid >> 6);
    float* gu = (float*)(lds + GL_GU); float* gbv = (float*)(lds + GL_GB); f32x2* tab = (f32x2*)(lds + GL_TAB);
    float* gbuf = (float*)(lds + GL_GBUF); float* tot = (float*)(lds + GL_TOT);
    bf16_t* qe = (bf16_t*)(lds + GL_QE); bf16_t* ke = (bf16_t*)(lds + GL_KE); bf16_t* att = (bf16_t*)(lds + GL_ATT);
    const bf16_t* P = (const bf16_t*)(p.ws + WS_P);
    bf16_t* GQ = (bf16_t*)(p.ws + WS_GQ); bf16_t* GK = (bf16_t*)(p.ws + WS_GK); bf16_t* GA = (bf16_t*)(p.ws + WS_GATT); float* GE = (float*)(p.ws + WS_GBLE);
    const int i = tid >> 3, dg = tid & 7;
    const int fr = lane & 15, fq = lane >> 4;
    __syncthreads();
    { const f32x2* rt = (const f32x2*)(p.ws + WS_ROPE); for (int e = tid; e < 2048; e += 512) tab[e] = rt[e]; }
    for (int it = blockIdx.x; it < 32 * 68; it += gridDim.x) {
        const int chain = it / 68, ci = it % 68; const int dir = chain & 1, h = (chain >> 1) & 3, b = chain >> 3;
        __syncthreads();
        for (int e = tid; e < 2048; e += 512) { const int r = e >> 7, d = e & 127; gu[e] = p.gate_up[(dir * 16 + r) * 512 + h * 128 + d]; }
        if (tid < 128) gbv[tid] = p.gate_b[dir * 512 + h * 128 + tid];
        bool isl; int tok; size_t row; GLA_ROW(ci, i, row, tok, isl);
        const bf16_t* pr = P + row * NIN;
        const u32x4 rq0 = *(const u32x4*)(pr + C_Q + h * 128 + dg * 16), rq1 = *(const u32x4*)(pr + C_Q + h * 128 + dg * 16 + 8);
        const u32x4 rqp0 = *(const u32x4*)(pr + C_Q + h * 128 + (dg ^ 2) * 16), rqp1 = *(const u32x4*)(pr + C_Q + h * 128 + (dg ^ 2) * 16 + 8);
        const u32x4 rk0 = *(const u32x4*)(pr + C_K + h * 128 + dg * 16), rk1 = *(const u32x4*)(pr + C_K + h * 128 + dg * 16 + 8);
        const u32x4 rkp0 = *(const u32x4*)(pr + C_K + h * 128 + (dg ^ 2) * 16), rkp1 = *(const u32x4*)(pr + C_K + h * 128 + (dg ^ 2) * 16 + 8);
        const u32x4 rg0 = *(const u32x4*)(pr + C_GL + dir * 16), rg1 = *(const u32x4*)(pr + C_GL + dir * 16 + 8);
        __syncthreads();
        {
            float gl[16]; unpack8(rg0, gl); unpack8(rg1, gl + 8);
            float z[16];
#pragma unroll
            for (int j = 0; j < 16; ++j) z[j] = gbv[dg * 16 + j];
#pragma unroll
            for (int r = 0; r < 16; ++r) {
#pragma unroll
                for (int j4 = 0; j4 < 4; ++j4) { const f32x4 u4 = *(const f32x4*)(gu + r * 128 + dg * 16 + 4 * j4);
                    z[4 * j4 + 0] += gl[r] * u4.x; z[4 * j4 + 1] += gl[r] * u4.y; z[4 * j4 + 2] += gl[r] * u4.z; z[4 * j4 + 3] += gl[r] * u4.w; }
            }
#pragma unroll
            for (int j4 = 0; j4 < 4; ++j4) { f32x4 o; o.x = logsigf_(z[4 * j4]) * 0.0625f; o.y = logsigf_(z[4 * j4 + 1]) * 0.0625f; o.z = logsigf_(z[4 * j4 + 2]) * 0.0625f; o.w = logsigf_(z[4 * j4 + 3]) * 0.0625f;
                *(f32x4*)(gbuf + i * 132 + dg * 16 + 4 * j4) = o; }
        }
        __syncthreads();
        { const int d = tid & 127, seg = tid >> 7; float run = 0.f;
#pragma unroll
          for (int ii = 0; ii < 16; ++ii) { float* gp = gbuf + (seg * 16 + ii) * 132 + d; run += *gp; *gp = run; }
          tot[seg * 128 + d] = run; }
        __syncthreads();
        {
            const int seg = i >> 4;
            float q[16], qp[16], k[16], kp[16];
            unpack8(rq0, q); unpack8(rq1, q + 8); unpack8(rqp0, qp); unpack8(rqp1, qp + 8);
            unpack8(rk0, k); unpack8(rk1, k + 8); unpack8(rkp0, kp); unpack8(rkp1, kp + 8);
            const float qs = 0.08838834764831845f;
            if (isl) {
                const int posr = (dg < 4) ? (tok >> 6) : (tok & 63);
                const float sgn = (dg & 2) ? 1.f : -1.f;
                const f32x2* tp = tab + posr * 32 + (dg & 1) * 16;
#pragma unroll
                for (int j = 0; j < 16; ++j) { const f32x2 cs = tp[j];
                    q[j] = q[j] * cs.x + sgn * qp[j] * cs.y; k[j] = k[j] * cs.x + sgn * kp[j] * cs.y; }
            }
            unsigned qw[8], kw[8];
#pragma unroll
            for (int j2 = 0; j2 < 8; ++j2) {
                const int d0 = dg * 16 + 2 * j2;
                float b0 = gbuf[i * 132 + d0], b1 = gbuf[i * 132 + d0 + 1];
                if (seg > 0) { b0 += tot[d0]; b1 += tot[d0 + 1]; }
                if (seg > 1) { b0 += tot[128 + d0]; b1 += tot[128 + d0 + 1]; }
                if (seg > 2) { b0 += tot[256 + d0]; b1 += tot[256 + d0 + 1]; }
                const float e0 = __expf(b0), e1 = __expf(b1), n0 = __expf(-b0), n1 = __expf(-b1);
                if (i == 63) { GE[(size_t)it * 128 + d0] = e0; GE[(size_t)it * 128 + d0 + 1] = e1; }
                qw[j2] = pk2(q[2 * j2] * qs * e0, q[2 * j2 + 1] * qs * e1);
                kw[j2] = pk2(k[2 * j2] * n0, k[2 * j2 + 1] * n1);
            }
            const u32x4 q0 = (u32x4){qw[0], qw[1], qw[2], qw[3]}, q1 = (u32x4){qw[4], qw[5], qw[6], qw[7]}, k0 = (u32x4){kw[0], kw[1], kw[2], kw[3]}, k1 = (u32x4){kw[4], kw[5], kw[6], kw[7]};
            *(u32x4*)(qe + i * 136 + dg * 16) = q0; *(u32x4*)(qe + i * 136 + dg * 16 + 8) = q1;
            *(u32x4*)(ke + i * 136 + dg * 16) = k0; *(u32x4*)(ke + i * 136 + dg * 16 + 8) = k1;
            bf16_t* gq = GQ + (size_t)it * 8192 + i * 128 + dg * 16; bf16_t* gk = GK + (size_t)it * 8192 + i * 128 + dg * 16;
            *(u32x4*)gq = q0; *(u32x4*)(gq + 8) = q1; *(u32x4*)gk = k0; *(u32x4*)(gk + 8) = k1;
        }
        __syncthreads();
        {
            const int tr = w >> 1;
#pragma unroll
            for (int c2 = 0; c2 < 2; ++c2) { const int tc = (w & 1) * 2 + c2;
                f32x4 a = (f32x4){0.f, 0.f, 0.f, 0.f};
                if (tc <= tr) {
#pragma unroll
                    for (int ks = 0; ks < 4; ++ks) { const bf16x8 A = *(const bf16x8*)(qe + (tr * 16 + fr) * 136 + ks * 32 + fq * 8); const bf16x8 B = *(const bf16x8*)(ke + (tc * 16 + fr) * 136 + ks * 32 + fq * 8);
                        a = __builtin_amdgcn_mfma_f32_16x16x32_bf16(A, B, a, 0, 0, 0); }
                }
#pragma unroll
                for (int j = 0; j < 4; ++j) { const int t = tr * 16 + fq * 4 + j, s2 = tc * 16 + fr; const float v = (s2 <= t) ? a[j] : 0.f; att[t * 72 + s2] = (bf16_t)f2bf(v); }
            }
        }
        __syncthreads();
        { const int t = tid >> 3, c8 = tid & 7; *(u32x4*)(GA + (size_t)it * 4096 + t * 64 + c8 * 8) = *(const u32x4*)(att + t * 72 + c8 * 8); }
    }
    __syncthreads();
}
__device__ __forceinline__ void gla_seq(const Params& p, unsigned char* lds, int gb) {
    const int tid = threadIdx.x, lane = tid & 63, w = __builtin_amdgcn_readfirstlane(tid >> 6);
    const int dvs = gb & 3, dir = (gb >> 2) & 1, h = (gb >> 3) & 3, b = gb >> 5;
    const int chain = (b * 4 + h) * 2 + dir;
    float* blE = (float*)(lds + GL_BLE); float* ostg = (float*)(lds + GL_GBUF);
    bf16_t* qe = (bf16_t*)(lds + GL_QE); bf16_t* ke = (bf16_t*)(lds + GL_KE); bf16_t* vt = (bf16_t*)(lds + GL_VT);
    bf16_t* att = (bf16_t*)(lds + GL_ATT); bf16_t* St = (bf16_t*)(lds + GL_ST);
    const bf16_t* GQ = (const bf16_t*)(p.ws + WS_GQ) + (size_t)chain * 68 * 8192; const bf16_t* GK = (const bf16_t*)(p.ws + WS_GK) + (size_t)chain * 68 * 8192;
    const bf16_t* GA = (const bf16_t*)(p.ws + WS_GATT) + (size_t)chain * 68 * 4096; const float* GE = (const float*)(p.ws + WS_GBLE) + (size_t)chain * 68 * 128;
    bf16_t* obuf = (bf16_t*)(p.ws + (dir ? WS_OB : WS_OF));
    const int i = tid >> 3, dg = tid & 7;
    const int fr = lane & 15, fq = lane >> 4;
    const bf16_t* VT = (const bf16_t*)(p.ws + WS_VT) + (size_t)(h * 256 + dvs * 64 + i) * MALL;
    __syncthreads();
    for (int e = tid; e < 64 * 136 / 2; e += 512) ((unsigned*)St)[e] = 0u;
    f32x4 S[4];
#pragma unroll
    for (int q = 0; q < 4; ++q) S[q] = (f32x4){0.f, 0.f, 0.f, 0.f};
    u32x4 RA[6], RB[6]; float reA, reB;
#define GS_LOAD(R, re, ci) do { const bf16_t* gq = GQ + (size_t)(ci) * 8192 + i * 128 + dg * 16; const bf16_t* gk = GK + (size_t)(ci) * 8192 + i * 128 + dg * 16; \
        R[0] = *(const u32x4*)gq; R[1] = *(const u32x4*)(gq + 8); R[2] = *(const u32x4*)gk; R[3] = *(const u32x4*)(gk + 8); \
        R[4] = *(const u32x4*)(GA + (size_t)(ci) * 4096 + i * 64 + dg * 8); \
        { const bool isl_ = (ci) >= 4; const int cc2_ = isl_ ? (ci) - 4 : (ci); const int n2_ = isl_ ? SEQ : CTX; const int tlo_ = dir ? n2_ - 64 - cc2_ * 64 : cc2_ * 64; \
          R[5] = *(const u32x4*)(VT + (isl_ ? (size_t)b * SEQ : (size_t)MLAT + b * CTX) + tlo_ + 8 * dg); } \
        re = (tid < 128) ? GE[(size_t)(ci) * 128 + tid] : 0.f; } while (0)
#define GS_BODY(R, re, ci) do { \
        *(u32x4*)(qe + i * 136 + dg * 16) = R[0]; *(u32x4*)(qe + i * 136 + dg * 16 + 8) = R[1]; \
        *(u32x4*)(ke + i * 136 + dg * 16) = R[2]; *(u32x4*)(ke + i * 136 + dg * 16 + 8) = R[3]; \
        *(u32x4*)(att + i * 72 + dg * 8) = R[4]; \
        if (dir == 0) *(u32x4*)(vt + i * 72 + 8 * dg) = R[5]; \
        else { u32x4 o; o.x = (R[5].w >> 16) | (R[5].w << 16); o.y = (R[5].z >> 16) | (R[5].z << 16); o.z = (R[5].y >> 16) | (R[5].y << 16); o.w = (R[5].x >> 16) | (R[5].x << 16); *(u32x4*)(vt + i * 72 + 56 - 8 * dg) = o; } \
        if (tid < 128) blE[tid] = re; \
        if ((ci) + 2 < 68) GS_LOAD(R, re, (ci) + 2); \
        __syncthreads(); \
        { \
            const int tr = w >> 1; \
            _Pragma("unroll") for (int c2 = 0; c2 < 2; ++c2) { const int vc = (w & 1) * 2 + c2; \
                f32x4 a = (f32x4){0.f, 0.f, 0.f, 0.f}; \
                _Pragma("unroll") for (int ks = 0; ks < 4; ++ks) { const bf16x8 A = *(const bf16x8*)(qe + (tr * 16 + fr) * 136 + ks * 32 + fq * 8); const bf16x8 B = *(const bf16x8*)(St + (vc * 16 + fr) * 136 + ks * 32 + fq * 8); \
                    a = __builtin_amdgcn_mfma_f32_16x16x32_bf16(A, B, a, 0, 0, 0); } \
                _Pragma("unroll") for (int ks = 0; ks < 2; ++ks) { const bf16x8 A = *(const bf16x8*)(att + (tr * 16 + fr) * 72 + ks * 32 + fq * 8); const bf16x8 B = *(const bf16x8*)(vt + (vc * 16 + fr) * 72 + ks * 32 + fq * 8); \
                    a = __builtin_amdgcn_mfma_f32_16x16x32_bf16(A, B, a, 0, 0, 0); } \
                _Pragma("unroll") for (int j = 0; j < 4; ++j) ostg[(tr * 16 + fq * 4 + j) * 68 + vc * 16 + fr] = a[j]; \
            } \
            _Pragma("unroll") for (int ks = 0; ks < 2; ++ks) { \
                bf16x8 A; \
                _Pragma("unroll") for (int j = 0; j < 8; ++j) A[j] = (short)ke[(ks * 32 + fq * 8 + j) * 136 + 16 * w + fr]; \
                _Pragma("unroll") for (int vc = 0; vc < 4; ++vc) { const bf16x8 B = *(const bf16x8*)(vt + (vc * 16 + fr) * 72 + ks * 32 + fq * 8); \
                    S[vc] = __builtin_amdgcn_mfma_f32_16x16x32_bf16(A, B, S[vc], 0, 0, 0); } \
            } \
            const f32x4 sc = *(const f32x4*)(blE + 16 * w + fq * 4); \
            _Pragma("unroll") for (int vc = 0; vc < 4; ++vc) S[vc] = S[vc] * sc; \
        } \
        __syncthreads(); \
        _Pragma("unroll") for (int vc = 0; vc < 4; ++vc) { u32x2 o; o.x = pk2(S[vc][0], S[vc][1]); o.y = pk2(S[vc][2], S[vc][3]); *(u32x2*)(St + (vc * 16 + fr) * 136 + 16 * w + fq * 4) = o; } \
        { bool isl2; int tok2; size_t row2; GLA_ROW(ci, i, row2, tok2, isl2);     \
          bf16_t* od = obuf + row2 * 1024 + h * 256 + dvs * 64 + dg * 8; \
          const f32x4 o0_ = *(const f32x4*)(ostg + i * 68 + dg * 8), o1_ = *(const f32x4*)(ostg + i * 68 + dg * 8 + 4); \
          *(u32x4*)od = (u32x4){pk2(o0_[0], o0_[1]), pk2(o0_[2], o0_[3]), pk2(o1_[0], o1_[1]), pk2(o1_[2], o1_[3])}; } \
    } while (0)
    GS_LOAD(RA, reA, 0); GS_LOAD(RB, reB, 1);
    for (int ci = 0; ci < 68; ci += 2) { GS_BODY(RA, reA, ci); GS_BODY(RB, reB, ci + 1); }
    __syncthreads();
#undef GS_LOAD
#undef GS_BODY
}

constexpr int LR_BA = 0, LR_BX = 34816, LR_XCB = 69632, LR_XC32 = 87040, LR_CW = 120832, LR_END = 123392;
static_assert(LR_END <= LDS_BYTES, "lru lds");
constexpr size_t DO_PC0 = 0, DO_PC1 = 34 * MiB, DO_TOT = 68 * MiB;
__device__ __forceinline__ float expm1_neg(float x) {
    return (x > -0.02f) ? x * (1.f + x * (0.5f + x * (0.16666667f + x * 0.041666667f))) : __expf(x) - 1.f;
}
__device__ __forceinline__ void lru_pre(const Params& p, unsigned char* lds) {
    const int tid = threadIdx.x, lane = tid & 63, w = __builtin_amdgcn_readfirstlane(tid >> 6);
    const int dgi = blockIdx.x & 15, sub = blockIdx.x >> 4, nsub = (gridDim.x - dgi + 15) >> 4;
    const int g = dgi & 7, dir = dgi >> 3, c0 = 128 * g;
    bf16_t* Ba = (bf16_t*)(lds + LR_BA); bf16_t* Bx = (bf16_t*)(lds + LR_BX); bf16_t* xcb = (bf16_t*)(lds + LR_XCB);
    float* xc32 = (float*)(lds + LR_XC32); float* cw = (float*)(lds + LR_CW);
    const bf16_t* P = (const bf16_t*)(p.ws + WS_P);
    bf16_t* hbuf = (bf16_t*)(p.ws + (dir ? WS_HB : WS_HF));
    bf16_t* pcbuf = (bf16_t*)((unsigned char*)p.out + (dir ? DO_PC1 : DO_PC0));
    float* totP = (float*)((unsigned char*)p.out + DO_TOT); float* totH = totP + (size_t)8 * 68 * 1024;
    __syncthreads();
    { const u32x4* img = (const u32x4*)(p.ws + WS_LRUW + (size_t)(dir * 8 + g) * 2 * (128 * 136 * 2)); u32x4* dst = (u32x4*)Ba;
      for (int e = tid; e < 2 * 34816 / 16; e += 512) dst[e] = img[e]; }
    for (int e = tid; e < 640; e += 512) { const int j = e >> 7, c = e & 127; cw[e] = j < 4 ? p.conv_w[j * 1024 + c0 + c] : p.conv_b[c0 + c]; }
    __syncthreads();
    const int fr = lane & 15, fq = lane >> 4;
    const int ch = c0 + 16 * w + fr;
    const float ba = p.b_a[dir * 1024 + ch], bx = p.b_x[dir * 1024 + ch];
    const float ls8 = 8.f * logsigf_(p.lam[dir * 1024 + ch]);
    bf16x8 WA[4], WX[4];
#pragma unroll
    for (int ks = 0; ks < 4; ++ks) { WA[ks] = *(const bf16x8*)(Ba + (16 * w + fr) * 136 + ks * 32 + fq * 8); WX[ks] = *(const bf16x8*)(Bx + (16 * w + fr) * 136 + ks * 32 + fq * 8); }
    __syncthreads();
    bf16_t* hst = Ba; bf16_t* pst = Bx;
    const int i = tid >> 3, cgp = tid & 7;
    u32x4 rx[4][2];
#define LRU_LOAD(idx) do { const int b_ = (idx) / 68, ci_ = (idx) % 68; const bool isl_ = ci_ >= 4; const int cc_ = isl_ ? ci_ - 4 : ci_; const int n_ = isl_ ? SEQ : CTX; const int pos_ = cc_ * 64 + i; \
        const int tok_ = dir ? n_ - 1 - pos_ : pos_; const size_t rb_ = isl_ ? (size_t)b_ * SEQ : (size_t)MLAT + b_ * CTX; \
        _Pragma("unroll") for (int j = 0; j < 4; ++j) { const int tt_ = tok_ + j - 2; \
            if (tt_ >= 0 && tt_ < n_) { const bf16_t* pr = P + (rb_ + tt_) * NIN + C_XR + c0 + cgp * 16; rx[j][0] = *(const u32x4*)pr; rx[j][1] = *(const u32x4*)(pr + 8); } \
            else { rx[j][0] = (u32x4){0u, 0u, 0u, 0u}; rx[j][1] = (u32x4){0u, 0u, 0u, 0u}; } } } while (0)
    if (sub < 272) LRU_LOAD(sub);
    for (int idx = sub; idx < 272; idx += nsub) {
        const int b = idx / 68, ci = idx % 68;
        const bool isl = ci >= 4; const int cc = isl ? ci - 4 : ci; const int n = isl ? SEQ : CTX; const size_t rb = isl ? (size_t)b * SEQ : (size_t)MLAT + b * CTX;
        {
            float xc[16];
#pragma unroll
            for (int j = 0; j < 16; ++j) xc[j] = cw[4 * 128 + cgp * 16 + j];
#pragma unroll
            for (int t4 = 0; t4 < 4; ++t4) { float xv[16]; unpack8(rx[t4][0], xv); unpack8(rx[t4][1], xv + 8);
#pragma unroll
                for (int j = 0; j < 16; ++j) xc[j] += xv[j] * cw[t4 * 128 + cgp * 16 + j]; }
#pragma unroll
            for (int j4 = 0; j4 < 4; ++j4) *(f32x4*)(xc32 + i * 132 + cgp * 16 + 4 * j4) = (f32x4){xc[4 * j4], xc[4 * j4 + 1], xc[4 * j4 + 2], xc[4 * j4 + 3]};
            *(u32x4*)(xcb + i * 136 + cgp * 16) = (u32x4){pk2(xc[0], xc[1]), pk2(xc[2], xc[3]), pk2(xc[4], xc[5]), pk2(xc[6], xc[7])};
            *(u32x4*)(xcb + i * 136 + cgp * 16 + 8) = (u32x4){pk2(xc[8], xc[9]), pk2(xc[10], xc[11]), pk2(xc[12], xc[13]), pk2(xc[14], xc[15])};
            if (idx + nsub < 272) LRU_LOAD(idx + nsub);
        }
        __syncthreads();
        float hcar = 0.f, pcar = 1.f;
#pragma unroll
        for (int tt = 0; tt < 4; ++tt) {
            f32x4 ar = (f32x4){0.f, 0.f, 0.f, 0.f}, ai = (f32x4){0.f, 0.f, 0.f, 0.f};
#pragma unroll
            for (int ks = 0; ks < 4; ++ks) { const bf16x8 A = *(const bf16x8*)(xcb + (tt * 16 + fr) * 136 + ks * 32 + fq * 8);
                ar = __builtin_amdgcn_mfma_f32_16x16x32_bf16(A, WA[ks], ar, 0, 0, 0); ai = __builtin_amdgcn_mfma_f32_16x16x32_bf16(A, WX[ks], ai, 0, 0, 0); }
            float Pj[4], Hj[4];
            float Pl = 1.f, Hl = 0.f;
#pragma unroll
            for (int j = 0; j < 4; ++j) { const int ii = tt * 16 + fq * 4 + j;
                const float r = sigmoidf_(ar[j] + ba), ig = sigmoidf_(ai[j] + bx);
                const float la = r * ls8; const float a = __expf(la);
                const float xcv = xc32[ii * 132 + 16 * w + fr];
                const float u = sqrtf(fmaxf(-expm1_neg(2.f * la), 0.f)) * (ig * xcv);
                Pl = a * Pl; Hl = a * Hl + u; Pj[j] = Pl; Hj[j] = Hl; }
            float Pi = Pl, Hi = Hl;
            { const float Pp = __shfl_up(Pi, 16), Hp = __shfl_up(Hi, 16); if (fq >= 1) { Hi = Pi * Hp + Hi; Pi = Pp * Pi; } }
            { const float Pp = __shfl_up(Pi, 32), Hp = __shfl_up(Hi, 32); if (fq >= 2) { Hi = Pi * Hp + Hi; Pi = Pp * Pi; } }
            float Pe = __shfl_up(Pi, 16), He = __shfl_up(Hi, 16); if (fq == 0) { Pe = 1.f; He = 0.f; }
            const float sin_ = Pe * hcar + He, pin_ = Pe * pcar;
            const float Pt = __shfl(Pi, 48 + fr), Ht = __shfl(Hi, 48 + fr);
#pragma unroll
            for (int j = 0; j < 4; ++j) { const int ii = tt * 16 + fq * 4 + j; const int pos = cc * 64 + ii; const int tok = dir ? n - 1 - pos : pos;
                hst[ii * 136 + 16 * w + fr] = (bf16_t)f2bf(Pj[j] * sin_ + Hj[j]);
                pst[ii * 136 + 16 * w + fr] = (bf16_t)f2bf(Pj[j] * pin_); }
            hcar = Pt * hcar + Ht; pcar = Pt * pcar;
        }
        if (fq == 0) { const size_t to = ((size_t)(b * 2 + dir) * 68 + ci) * 1024 + ch; totP[to] = pcar; totH[to] = hcar; }
        __syncthreads();
        { const int pos = cc * 64 + i; const int tok = dir ? n - 1 - pos : pos; const size_t go = (rb + tok) * 1024 + c0 + cgp * 16;
          const u32x4 h0 = *(const u32x4*)(hst + i * 136 + cgp * 16), h1 = *(const u32x4*)(hst + i * 136 + cgp * 16 + 8);
          const u32x4 p0 = *(const u32x4*)(pst + i * 136 + cgp * 16), p1 = *(const u32x4*)(pst + i * 136 + cgp * 16 + 8);
          *(u32x4*)(hbuf + go) = h0; *(u32x4*)(hbuf + go + 8) = h1; *(u32x4*)(pcbuf + go) = p0; *(u32x4*)(pcbuf + go + 8) = p1; }
    }
#undef LRU_LOAD
}
__device__ __forceinline__ void lru_apply(const Params& p, int role) {
    const int tid = threadIdx.x;
    const int cg64 = role & 15, dir = (role >> 4) & 1, b = role >> 5;
    const int i = tid >> 3, c8 = tid & 7; const int ch = cg64 * 64 + c8 * 8;
    bf16_t* hbuf = (bf16_t*)(p.ws + (dir ? WS_HB : WS_HF));
    const bf16_t* pcbuf = (const bf16_t*)((const unsigned char*)p.out + (dir ? DO_PC1 : DO_PC0));
    const float* totP = (const float*)((const unsigned char*)p.out + DO_TOT) + (size_t)(b * 2 + dir) * 68 * 1024 + ch; const float* totH = totP + (size_t)8 * 68 * 1024;
    float cin[8];
#pragma unroll
    for (int j = 0; j < 8; ++j) cin[j] = 0.f;
    for (int c4 = 0; c4 < 68; c4 += 4) {
        u32x4 pw[4], hw[4]; f32x4 tp[4][2], th[4][2]; size_t off[4];
#pragma unroll
        for (int q = 0; q < 4; ++q) { const int ci = c4 + q;
            const bool isl = ci >= 4; const int cc = isl ? ci - 4 : ci; const int n = isl ? SEQ : CTX; const size_t rb = isl ? (size_t)b * SEQ : (size_t)MLAT + b * CTX;
            const int pos = cc * 64 + i; const int tok = dir ? n - 1 - pos : pos;
            off[q] = (rb + tok) * 1024 + ch;
            pw[q] = *(const u32x4*)(pcbuf + off[q]); hw[q] = *(const u32x4*)(hbuf + off[q]);
            tp[q][0] = *(const f32x4*)(totP + (size_t)ci * 1024); tp[q][1] = *(const f32x4*)(totP + (size_t)ci * 1024 + 4);
            th[q][0] = *(const f32x4*)(totH + (size_t)ci * 1024); th[q][1] = *(const f32x4*)(totH + (size_t)ci * 1024 + 4); }
#pragma unroll
        for (int q = 0; q < 4; ++q) {
            float pc[8], hl[8]; unpack8(pw[q], pc); unpack8(hw[q], hl);
            float hv[8];
#pragma unroll
            for (int j = 0; j < 8; ++j) hv[j] = pc[j] * cin[j] + hl[j];
            *(u32x4*)(hbuf + off[q]) = (u32x4){pk2(hv[0], hv[1]), pk2(hv[2], hv[3]), pk2(hv[4], hv[5]), pk2(hv[6], hv[7])};
            const float tpv[8] = {tp[q][0].x, tp[q][0].y, tp[q][0].z, tp[q][0].w, tp[q][1].x, tp[q][1].y, tp[q][1].z, tp[q][1].w};
            const float thv[8] = {th[q][0].x, th[q][0].y, th[q][0].z, th[q][0].w, th[q][1].x, th[q][1].y, th[q][1].z, th[q][1].w};
#pragma unroll
            for (int j = 0; j < 8; ++j) cin[j] = tpv[j] * cin[j] + thv[j];
        }
    }
}

__device__ __forceinline__ void phase_merge(const Params& p) {
    const int lane = threadIdx.x & 63, gw = blockIdx.x * 8 + (threadIdx.x >> 6), NGW = gridDim.x * 8;
    const bf16_t* P = (const bf16_t*)(p.ws + WS_P); const bf16_t* of = (const bf16_t*)(p.ws + WS_OF); const bf16_t* ob = (const bf16_t*)(p.ws + WS_OB);
    const bf16_t* hf = (const bf16_t*)(p.ws + WS_HF); const bf16_t* hb = (const bf16_t*)(p.ws + WS_HB); bf16_t* A = (bf16_t*)(p.ws + WS_A);
    for (int m = gw; m < MALL; m += NGW) {
        const bf16_t* pr = P + (size_t)m * NIN;
        u32x2 wf[4], wb[4], og[4], ha[4], hbv[4], yv[4];
#pragma unroll
        for (int h = 0; h < 4; ++h) { const int c = h * 256 + 4 * lane;
            wf[h] = *(const u32x2*)(of + (size_t)m * 1024 + c); wb[h] = *(const u32x2*)(ob + (size_t)m * 1024 + c); og[h] = *(const u32x2*)(pr + C_OG + c);
            ha[h] = *(const u32x2*)(hf + (size_t)m * 1024 + c); hbv[h] = *(const u32x2*)(hb + (size_t)m * 1024 + c); yv[h] = *(const u32x2*)(pr + C_YR + c); }
#pragma unroll
        for (int h = 0; h < 4; ++h) { const int c = h * 256 + 4 * lane;
            const f32x4 o = (f32x4){bflo(wf[h].x) + bflo(wb[h].x), bfhi(wf[h].x) + bfhi(wb[h].x), bflo(wf[h].y) + bflo(wb[h].y), bfhi(wf[h].y) + bfhi(wb[h].y)};
            const float ss = wave_sum((o.x * o.x + o.y * o.y) + (o.z * o.z + o.w * o.w));
            const float rstd = rsqrtf(ss * (1.f / 256.f) + EPS);
            const f32x4 gg = *(const f32x4*)(p.gla_g + c);
            const float r0 = o.x * rstd * gg.x * siluf_(bflo(og[h].x)), r1 = o.y * rstd * gg.y * siluf_(bfhi(og[h].x));
            const float r2 = o.z * rstd * gg.z * siluf_(bflo(og[h].y)), r3 = o.w * rstd * gg.w * siluf_(bfhi(og[h].y));
            *(u32x2*)(A + (size_t)m * D + c) = (u32x2){pk2(r0, r1), pk2(r2, r3)}; }
#pragma unroll
        for (int j = 0; j < 4; ++j) { const int c = 256 * j + 4 * lane;
            const u32x2 a = ha[j], bb = hbv[j], y = yv[j];
            const float r0 = (bflo(a.x) + bflo(bb.x)) * gelu_tanh(bflo(y.x)), r1 = (bfhi(a.x) + bfhi(bb.x)) * gelu_tanh(bfhi(y.x));
            const float r2 = (bflo(a.y) + bflo(bb.y)) * gelu_tanh(bflo(y.y)), r3 = (bfhi(a.y) + bfhi(bb.y)) * gelu_tanh(bfhi(y.y));
            *(u32x2*)(A + (size_t)m * D + 1024 + c) = (u32x2){pk2(r0, r1), pk2(r2, r3)}; }
    }
}

constexpr int NA_KT = 0, NA_VT = 34816, NA_PW = 71680, NA_RB = 108544, NA_END = 110592;
static_assert(NA_END <= LDS_BYTES, "na lds");
__device__ __forceinline__ void phase_na(const Params& p, unsigned char* lds) {
    const int tid = threadIdx.x, lane = tid & 63, w = __builtin_amdgcn_readfirstlane(tid >> 6), fr = lane & 15, fq = lane >> 4;
    bf16_t* KtB = (bf16_t*)(lds + NA_KT); bf16_t* vtB = (bf16_t*)(lds + NA_VT); bf16_t* Pw = (bf16_t*)(lds + NA_PW) + w * (32 * 72); float* rbt = (float*)(lds + NA_RB);
    const bf16_t* QK = (const bf16_t*)(p.ws + WS_P); const bf16_t* VTg = (const bf16_t*)(p.ws + WS_VT); bf16_t* O = (bf16_t*)(p.ws + WS_A);
    const int key = tid >> 3, part = tid & 7;
    const int vd = tid >> 2, vc4 = tid & 3;
    const float scale = 0.08838834764831845f * 1.4426950408889634f;
    for (int u = blockIdx.x; u < 1024; u += gridDim.x) {
        const int r4 = u & 15, h = (u >> 4) & 15, b = u >> 8, r0 = 4 * r4;
        const int rs_lo = min(max(r0 - 4, 0), 56), rs_hi = min(max(r0 - 1, 0), 56);
        const int ntile = 4 + (rs_hi + 8 - rs_lo);
        const int qr = r0 + (w >> 1), qc0 = 32 * (w & 1);
        const int rsq = min(max(qr - 4, 0), 56);
        __syncthreads();
        for (int e = tid; e < 465; e += 512) rbt[e] = p.rel_bias[h * 465 + e] * 1.4426950408889634f;
        bf16x8 aq[2][4];
#pragma unroll
        for (int mt = 0; mt < 2; ++mt) { const bf16_t* qp = QK + (size_t)(b * SEQ + qr * 64 + qc0 + 16 * mt + fr) * NQK + h * 128 + fq * 8;
#pragma unroll
            for (int ks = 0; ks < 4; ++ks) aq[mt][ks] = *(const bf16x8*)(qp + ks * 32); }
        f32x4 Oa[2][8];
#pragma unroll
        for (int mt = 0; mt < 2; ++mt)
#pragma unroll
            for (int dt = 0; dt < 8; ++dt) Oa[mt][dt] = (f32x4){0.f, 0.f, 0.f, 0.f};
        float mrow[2] = {-1e30f, -1e30f}, lrow[2] = {0.f, 0.f};
        u32x4 ra[4];
#define NA_LOAD(R, kt) do { const size_t row0_ = (kt) < 4 ? (size_t)MLAT + b * CTX + (kt) * 64 : (size_t)b * SEQ + (rs_lo + (kt) - 4) * 64; \
        const bf16_t* pk = QK + (row0_ + key) * NQK + D + h * 128 + part * 16; const bf16_t* pv = VTg + (size_t)(h * 128 + vd) * MALL + row0_ + vc4 * 16; \
        R[0] = *(const u32x4*)pk; R[1] = *(const u32x4*)(pk + 8); R[2] = *(const u32x4*)pv; R[3] = *(const u32x4*)(pv + 8); } while (0)
#define NA_WRITE(R, buf) do { bf16_t* kd = KtB + (buf) * (64 * 136) + key * 136 + part * 16; bf16_t* vdp = vtB + (buf) * (128 * 72) + vd * 72 + vc4 * 16; \
        *(u32x4*)kd = R[0]; *(u32x4*)(kd + 8) = R[1]; *(u32x4*)vdp = R[2]; *(u32x4*)(vdp + 8) = R[3]; } while (0)
        NA_LOAD(ra, 0); NA_WRITE(ra, 0);
        NA_LOAD(ra, 1);
        __syncthreads();
        for (int kt = 0; kt < ntile; ++kt) {
            if (kt + 1 < ntile) { NA_WRITE(ra, (kt + 1) & 1); if (kt + 2 < ntile) NA_LOAD(ra, kt + 2); }
            const bool band = kt >= 4; const int kr = rs_lo + kt - 4;
            if (!(band && (kr < rsq || kr >= rsq + 8))) {
                const bf16_t* Kt = KtB + (kt & 1) * (64 * 136); const bf16_t* vt = vtB + (kt & 1) * (128 * 72);
                f32x4 st[2][4];
                const int wlo0 = min(max(qc0 - 8, 0), 48), whi0 = min(max(qc0 + 7, 0), 48) + 16, wlo1 = min(max(qc0 + 8, 0), 48), whi1 = min(max(qc0 + 23, 0), 48) + 16;
#pragma unroll
                for (int nt = 0; nt < 4; ++nt) {
                    const bool act0 = !band || (16 * nt < whi0 && 16 * nt + 16 > wlo0), act1 = !band || (16 * nt < whi1 && 16 * nt + 16 > wlo1);
                    st[0][nt] = (f32x4){0.f, 0.f, 0.f, 0.f}; st[1][nt] = (f32x4){0.f, 0.f, 0.f, 0.f};
                    if (act0 || act1) {
                        bf16x8 Bk[4];
#pragma unroll
                        for (int ks = 0; ks < 4; ++ks) Bk[ks] = *(const bf16x8*)(Kt + (nt * 16 + fr) * 136 + ks * 32 + fq * 8);
#pragma unroll
                        for (int ks = 0; ks < 4; ++ks) {
                            if (act0) st[0][nt] = __builtin_amdgcn_mfma_f32_16x16x32_bf16(Bk[ks], aq[0][ks], st[0][nt], 0, 0, 0);
                            if (act1) st[1][nt] = __builtin_amdgcn_mfma_f32_16x16x32_bf16(Bk[ks], aq[1][ks], st[1][nt], 0, 0, 0); }
                    }
                }
                unsigned pk[2][4][2];
#pragma unroll
                for (int mt = 0; mt < 2; ++mt) {
                    __builtin_amdgcn_sched_barrier(0);
                    const int c = qc0 + 16 * mt + fr; const int cs = min(max(c - 8, 0), 48); const int wlo = mt ? wlo1 : wlo0, whi = mt ? whi1 : whi0;
                    float mx = -1e30f;
#pragma unroll
                    for (int nt = 0; nt < 4; ++nt) {
                        const bool act = !band || (16 * nt < whi && 16 * nt + 16 > wlo);
                        if (act) {
#pragma unroll
                            for (int j = 0; j < 4; ++j) { float v = st[mt][nt][j] * scale;
                                if (band) { const int kc = nt * 16 + fq * 4 + j; const bool valid = kc >= cs && kc < cs + 16; const int dci = min(max(kc - c + 15, 0), 30);
                                    v += rbt[(kr - qr + 7) * 31 + dci]; v = valid ? v : -1e30f; }
                                st[mt][nt][j] = v; mx = fmaxf(mx, v); }
                        }
                    }
                    mx = fmaxf(mx, __shfl_xor(mx, 16)); mx = fmaxf(mx, __shfl_xor(mx, 32));
                    const bool resc = !__all(mx - mrow[mt] <= 8.0f);
                    float mn = mrow[mt], alpha = 1.f;
                    if (resc) { mn = fmaxf(mrow[mt], mx); alpha = __builtin_amdgcn_exp2f(mrow[mt] - mn); mrow[mt] = mn; }
                    float ls = 0.f;
#pragma unroll
                    for (int nt = 0; nt < 4; ++nt) {
                        const bool act = !band || (16 * nt < whi && 16 * nt + 16 > wlo);
                        if (act) { const float p0 = __builtin_amdgcn_exp2f(st[mt][nt][0] - mn), p1 = __builtin_amdgcn_exp2f(st[mt][nt][1] - mn), p2 = __builtin_amdgcn_exp2f(st[mt][nt][2] - mn), p3 = __builtin_amdgcn_exp2f(st[mt][nt][3] - mn);
                            ls += (p0 + p1) + (p2 + p3); pk[mt][nt][0] = pk2(p0, p1); pk[mt][nt][1] = pk2(p2, p3); }
                        else { pk[mt][nt][0] = 0u; pk[mt][nt][1] = 0u; }
                    }
                    lrow[mt] = lrow[mt] * alpha + ls;
                    if (resc) {
#pragma unroll
                        for (int dt = 0; dt < 8; ++dt) Oa[mt][dt] = Oa[mt][dt] * alpha; }
                }
                __builtin_amdgcn_sched_barrier(0);
#pragma unroll
                for (int kk = 0; kk < 2; ++kk) {
                    const int ta = 2 * kk, tb = 2 * kk + 1;
                    const bf16x8 Bp0 = as_bf16x8((u32x4){pk[0][ta][0], pk[0][ta][1], pk[0][tb][0], pk[0][tb][1]}), Bp1 = as_bf16x8((u32x4){pk[1][ta][0], pk[1][ta][1], pk[1][tb][0], pk[1][tb][1]});
#pragma unroll
                    for (int dt = 0; dt < 8; ++dt) {
                        const u32x2 va = *(const u32x2*)(vt + (dt * 16 + fr) * 72 + 16 * ta + fq * 4), vb = *(const u32x2*)(vt + (dt * 16 + fr) * 72 + 16 * tb + fq * 4);
                        const bf16x8 Av = as_bf16x8((u32x4){va.x, va.y, vb.x, vb.y});
                        Oa[0][dt] = __builtin_amdgcn_mfma_f32_16x16x32_bf16(Av, Bp0, Oa[0][dt], 0, 0, 0);
                        Oa[1][dt] = __builtin_amdgcn_mfma_f32_16x16x32_bf16(Av, Bp1, Oa[1][dt], 0, 0, 0); }
                    __builtin_amdgcn_sched_group_barrier(0x100, 8, 0);
#pragma unroll
                    for (int q = 0; q < 4; ++q) { __builtin_amdgcn_sched_group_barrier(0x008, 2, 0); __builtin_amdgcn_sched_group_barrier(0x100, 2, 0); }
                    __builtin_amdgcn_sched_group_barrier(0x008, 8, 0);
                    __builtin_amdgcn_sched_barrier(0);
                }
            }
            __syncthreads();
        }
        { bf16_t* ost = KtB + w * (32 * 136);
#pragma unroll
          for (int mt = 0; mt < 2; ++mt) {
            float l = lrow[mt]; l += __shfl_xor(l, 16); l += __shfl_xor(l, 32); const float inv = 1.f / l;
#pragma unroll
            for (int dt = 0; dt < 8; ++dt) *(u32x2*)(ost + (mt * 16 + fr) * 136 + dt * 16 + fq * 4) = (u32x2){pk2(Oa[mt][dt][0] * inv, Oa[mt][dt][1] * inv), pk2(Oa[mt][dt][2] * inv, Oa[mt][dt][3] * inv)}; }
          asm volatile("s_waitcnt lgkmcnt(0)" ::: "memory");
          const int q = lane >> 1, hf = lane & 1;
          bf16_t* op = O + (size_t)(b * SEQ + qr * 64 + qc0 + q) * D + h * 128 + hf * 64;
#pragma unroll
          for (int e = 0; e < 8; ++e) *(u32x4*)(op + e * 8) = *(const u32x4*)(ost + q * 136 + hf * 64 + e * 8); }
#undef NA_LOAD
#undef NA_WRITE
    }
    __syncthreads();
}

__device__ __forceinline__ void phase_final(const Params& p) {
    const int lane = threadIdx.x & 63, gw = blockIdx.x * 8 + (threadIdx.x >> 6), NGW = gridDim.x * 8;
    for (int m = gw; m < MLAT; m += NGW) {
        float* xr = p.out + (size_t)m * D;
        f32x4 v[8]; float ss = 0.f;
#pragma unroll
        for (int j = 0; j < 8; ++j) { v[j] = *(const f32x4*)(xr + 256 * j + 4 * lane); ss += (v[j].x * v[j].x + v[j].y * v[j].y) + (v[j].z * v[j].z + v[j].w * v[j].w); }
        f32x4 gg[8];
#pragma unroll
        for (int j = 0; j < 8; ++j) gg[j] = *(const f32x4*)(p.fin_g + 256 * j + 4 * lane);
        const float rstd = rsqrtf(wave_sum(ss) * (1.f / D) + EPS);
#pragma unroll
        for (int j = 0; j < 8; ++j) *(f32x4*)(xr + 256 * j + 4 * lane) = v[j] * rstd * gg[j];
    }
}

#define XB_TMO      128
#define XB_XCNT(j)  (256  + 64 * (j))
#define XB_XSUB(j)  (1280 + 64 * (j))
#define XB_XGEN(j)  (2304 + 64 * (j))
#define XB_TOP      3328
#define XB_TOPGEN   3392
#define XCD_BAR_WORDS 3456
#define XB_SPIN_CAP (1u << 18)
__device__ __forceinline__ unsigned xb_ld(unsigned* p)              { return __hip_atomic_load(p, __ATOMIC_RELAXED, __HIP_MEMORY_SCOPE_AGENT); }
__device__ __forceinline__ unsigned xb_add(unsigned* p, unsigned v) { return __hip_atomic_fetch_add(p, v, __ATOMIC_RELAXED, __HIP_MEMORY_SCOPE_AGENT); }
__device__ __forceinline__ unsigned xb_xcc_id() { return (unsigned)__builtin_amdgcn_s_getreg((3 << 11) | 20) & 0xFu; }
#define XB_SPIN(cond, bar) do { unsigned _sp = 0; while (cond) { __builtin_amdgcn_s_sleep(1); \
    if ((++_sp & 255u) == 0u) { if (xb_ld(&(bar)[XB_TMO])) break; if (_sp > XB_SPIN_CAP) { atomicAdd(&(bar)[XB_TMO], 1u); break; } } } } while (0)
struct XcdBarrier { unsigned* bar; unsigned x; volatile LAS unsigned* st; };
__device__ __forceinline__ XcdBarrier xcd_barrier_post(unsigned* bar, volatile LAS unsigned* st) {
    XcdBarrier b; b.bar = bar; b.x = xb_xcc_id(); b.st = st;
    if (threadIdx.x == 0) (void)xb_add(&bar[XB_XCNT(b.x)], 1u);
    return b;
}
__device__ __forceinline__ void xcd_barrier_complete(unsigned* bar, unsigned x, unsigned& nloc, unsigned& nx) {
    const unsigned G = gridDim.x * gridDim.y * gridDim.z;
    unsigned sum, cnt, mine, sp = 0u;
    for (;;) {
        sum = 0u; cnt = 0u; mine = 0u;
#pragma unroll
        for (unsigned j = 0; j < 16; ++j) { const unsigned c = xb_ld(&bar[XB_XCNT(j)]); sum += c; cnt += (c > 0u) ? 1u : 0u; mine = (j == x) ? c : mine; }
        if (sum == G) break;
        __builtin_amdgcn_s_sleep(1);
        if ((++sp & 255u) == 0u) { if (xb_ld(&bar[XB_TMO])) break; if (sp > XB_SPIN_CAP) { atomicAdd(&bar[XB_TMO], 1u); break; } }
    }
    nloc = mine > 0u ? mine : 1u; nx = cnt > 0u ? cnt : 1u;
}
__device__ __forceinline__ void xcd_barrier(const XcdBarrier& b) {
    asm volatile("s_waitcnt vmcnt(0)" ::: "memory");
    __syncthreads();
    if (threadIdx.x == 0) {
        unsigned* bar = b.bar;
        __builtin_amdgcn_s_waitcnt(0);
        unsigned nloc = b.st[0], nx = b.st[1];
        if (nloc == 0u) { xcd_barrier_complete(bar, b.x, nloc, nx); b.st[0] = nloc; b.st[1] = nx; }
        const unsigned old = xb_add(&bar[XB_XSUB(b.x)], 1u);
        const unsigned gen = old / nloc;
        if (old + 1u == (gen + 1u) * nloc) {
            __builtin_amdgcn_fence(__ATOMIC_RELEASE, "agent");
            asm volatile("s_waitcnt vmcnt(0)" ::: "memory");
            const unsigned og = xb_add(&bar[XB_TOP], 1u);
            const unsigned tg = og / nx;
            if (og + 1u == (tg + 1u) * nx) xb_add(&bar[XB_TOPGEN], 1u);
            else XB_SPIN(xb_ld(&bar[XB_TOPGEN]) == tg, bar);
            __builtin_amdgcn_fence(__ATOMIC_ACQUIRE, "agent");
            xb_add(&bar[XB_XGEN(b.x)], 1u);
            asm volatile("s_waitcnt vmcnt(0)" ::: "memory");
        } else {
            XB_SPIN(xb_ld(&bar[XB_XGEN(b.x)]) == gen, bar);
            __builtin_amdgcn_fence(__ATOMIC_ACQUIRE, "agent");
            asm volatile("s_waitcnt vmcnt(0)" ::: "memory");
        }
    }
    __syncthreads();
}

constexpr int N_PHASES = 17;
#ifndef ONLYP
#define ONLYP -1
#endif
#define PH(k) (ONLYP < 0 || ONLYP == (k))
#ifndef REPP
#define REPP -1
#endif
#define NREP(k) ((REPP == (k)) ? 2 : 1)
__device__ __forceinline__ void run_gemm_store(const Params& p, LAS unsigned char* ldsl, const int ph) {
    unsigned char* ws = p.ws; const int l1 = ph >= 9; const int Mrows = ph >= 12 ? MLAT : MALL;
    const bf16_t* A = (const bf16_t*)(ws + WS_A);
    pg8::Gemm g{D}; pg8::SegOrder S; S.init(D, gridDim.x, blockIdx.x);
    pg8::EpiBf16 E{(bf16_t*)(ws + WS_P), NIN, (bf16_t*)(ws + WS_VT), MALL, 0};
    if (ph == 2) { S.add(A, ws + WS_WIN, MALL / 256, NIN / 256, 1, D / 64, 0); S.add(ws + WS_WV0, A, 1024 / 256, MALL / 256, 1, D / 64, 1); }
    else if (ph == 10) { E.ldc0 = NQK; S.add(A, ws + WS_WQKV, MALL / 256, NQK / 256, 1, D / 64, 0); S.add((const bf16_t*)(ws + WS_WQKV) + (size_t)NQK * D, A, D / 256, MALL / 256, 1, D / 64, 1); }
    else { E.O0 = (bf16_t*)(ws + WS_H); E.ldc0 = DFF; E.ACT = 1; S.add(A, (const bf16_t*)(ws + WS_WUP) + (size_t)l1 * D * DFF, Mrows / 256, DFF / 256, 1, D / 64, 0); }
    pg8::gemm_phase<pg8::EpiBf16, pg8::SegOrder, true, true>(ldsl, g, S, E);
}
__device__ __forceinline__ void run_gemm_resid(const Params& p, LAS unsigned char* ldsl, const int ph) {
    unsigned char* ws = p.ws; const int l1 = ph >= 9;
    const float* modl = (const float*)(ws + WS_MODV) + (size_t)l1 * 5 * (6 * D);
    float* xcb = (float*)(ws + WS_XC);
    const bool dn = (ph == 8 || ph == 15);
    const int K = dn ? DFF : D;
    const bf16_t* A = dn ? (const bf16_t*)(ws + WS_H) : (const bf16_t*)(ws + WS_A);
    const bf16_t* Bt = dn ? (const bf16_t*)(ws + WS_WDN) + (size_t)l1 * D * DFF : (ph == 5 ? (const bf16_t*)(ws + WS_WOUT) : (const bf16_t*)(ws + WS_WNO));
    pg8::Gemm g{K}; pg8::SegOrder S; S.init(K, gridDim.x, blockIdx.x);
    S.add(A, Bt, MLAT / 256, D / 256, 1, K / 64, 0);
    if (!l1) S.add(A + (size_t)MLAT * K, Bt, MCTX / 256, D / 256, 8, K / 64 / 8, 1);
    pg8::EpiResid E{ph == 5 ? p.x : p.out, p.out, (float*)(ws + WS_PART), modl + (dn ? 5 : 2) * D};
    pg8::gemm_phase<pg8::EpiResid, pg8::SegOrder, true, true>(ldsl, g, S, E);
}
__global__ void __launch_bounds__(512, 2) fwd_megakernel(Params p) {
    extern __shared__ __attribute__((aligned(16))) unsigned char lds[];
    cg::grid_group grid = cg::this_grid();
    LAS unsigned char* ldsl = (LAS unsigned char*)lds;
    const int lo = p.ph_lo, hi = p.ph_hi;
    float* xcb = (float*)(p.ws + WS_XC);
#define IN(k) (lo <= (k) && (k) < hi)
    if (threadIdx.x < 2) ((volatile LAS unsigned*)(ldsl + LDS_BYTES - 64))[threadIdx.x] = 0u;
    __syncthreads();
    const XcdBarrier xb = xcd_barrier_post((unsigned*)(p.ws + WS_BAR), (volatile LAS unsigned*)(ldsl + LDS_BYTES - 64));
    if (p.ph_hi > 1000) grid.sync();
#define GSYNC() xcd_barrier(xb)
#define SEAM(k) do { if (IN(k) && IN((k) + 1)) GSYNC(); } while (0)
    if (IN(0)) { for (int rep_ = 0; rep_ < NREP(0); ++rep_) { if (rep_) GSYNC(); if (PH(0)) phase_mod(p, lds, 0, 0, gridDim.x); } } SEAM(0);
    if (IN(1)) { for (int rep_ = 0; rep_ < NREP(1); ++rep_) { if (rep_) GSYNC(); if (PH(1)) { phase_convert(p, lds, 0, 0, gridDim.x, 0, 32 * 161); phase_modulate(p, p.x, p.ctx, p.norm1_g, 0, 0, MALL, -1, 0); } } } SEAM(1);
    if (IN(2)) { for (int rep_ = 0; rep_ < NREP(2); ++rep_) { if (rep_) GSYNC(); if (PH(2)) run_gemm_store(p, ldsl, 2); } } SEAM(2);
    if (IN(3)) { for (int rep_ = 0; rep_ < NREP(3); ++rep_) { if (rep_) GSYNC(); if (PH(3)) { gla_pre(p, lds); lru_pre(p, lds); GSYNC(); for (int role = blockIdx.x; role < 256; role += gridDim.x) { if (role < 128) gla_seq(p, lds, role); else lru_apply(p, role - 128); }
        { const int wb0 = gridDim.x >= 256 ? 128 : 0, nwb = gridDim.x - wb0; if ((int)blockIdx.x >= wb0) { phase_convert(p, lds, 0, wb0, nwb, 32 * 161); phase_convert(p, lds, 1, wb0, nwb); phase_mod(p, lds, 1, wb0, nwb);     } } } } } SEAM(3);
    if (IN(4)) { for (int rep_ = 0; rep_ < NREP(4); ++rep_) { if (rep_) GSYNC(); if (PH(4)) phase_merge(p); } } SEAM(4);
    if (IN(5)) { for (int rep_ = 0; rep_ < NREP(5); ++rep_) { if (rep_) GSYNC(); if (PH(5)) run_gemm_resid(p, ldsl, 5); } } SEAM(5);
    if (IN(6)) { for (int rep_ = 0; rep_ < NREP(6); ++rep_) { if (rep_) GSYNC(); if (PH(6)) phase_modulate(p, p.out, p.ctx, p.norm2_g, 0, 1, MALL, 2, 0); } } SEAM(6);
    if (IN(7)) { for (int rep_ = 0; rep_ < NREP(7); ++rep_) { if (rep_) GSYNC(); if (PH(7)) run_gemm_store(p, ldsl, 7); } } SEAM(7);
    if (IN(8)) { for (int rep_ = 0; rep_ < NREP(8); ++rep_) { if (rep_) GSYNC(); if (PH(8)) run_gemm_resid(p, ldsl, 8); } } SEAM(8);
    if (IN(9)) { for (int rep_ = 0; rep_ < NREP(9); ++rep_) { if (rep_) GSYNC(); if (PH(9)) phase_modulate(p, p.out, xcb, p.norm1_g + D, 1, 0, MALL, 5, 0); } } SEAM(9);
    if (IN(10)) { for (int rep_ = 0; rep_ < NREP(10); ++rep_) { if (rep_) GSYNC(); if (PH(10)) run_gemm_store(p, ldsl, 10); } } SEAM(10);
    if (IN(11)) { for (int rep_ = 0; rep_ < NREP(11); ++rep_) { if (rep_) GSYNC(); if (PH(11)) phase_na(p, lds); } } SEAM(11);
    if (IN(12)) { for (int rep_ = 0; rep_ < NREP(12); ++rep_) { if (rep_) GSYNC(); if (PH(12)) run_gemm_resid(p, ldsl, 12); } } SEAM(12);
    if (IN(13)) { for (int rep_ = 0; rep_ < NREP(13); ++rep_) { if (rep_) GSYNC(); if (PH(13)) phase_modulate(p, p.out, xcb, p.norm2_g + D, 1, 1, MLAT, -1, 0); } } SEAM(13);
    if (IN(14)) { for (int rep_ = 0; rep_ < NREP(14); ++rep_) { if (rep_) GSYNC(); if (PH(14)) run_gemm_store(p, ldsl, 14); } } SEAM(14);
    if (IN(15)) { for (int rep_ = 0; rep_ < NREP(15); ++rep_) { if (rep_) GSYNC(); if (PH(15)) run_gemm_resid(p, ldsl, 15); } } SEAM(15);
    if (IN(16)) { for (int rep_ = 0; rep_ < NREP(16); ++rep_) { if (rep_) GSYNC(); if (PH(16)) phase_final(p); } }
#undef IN
#undef SEAM
}

extern "C" void kernel_launch(void* const* d_in, const int* in_sizes, int n_in, void* d_out, int out_size, void* d_ws, size_t ws_size, hipStream_t stream) {
    static int grid = 0;
    if (grid == 0) {
        if (n_in != 26 || out_size != MLAT * D || ws_size < WS_END) { fprintf(stderr, "kernel_launch: unexpected shapes (n_in %d out %d ws %zu)\n", n_in, out_size, ws_size); grid = -1; return; }
        int dev = 0, cus = 0, per_cu = 0;
        hipGetDevice(&dev); hipDeviceGetAttribute(&cus, hipDeviceAttributeMultiprocessorCount, dev);
        hipFuncSetAttribute((const void*)fwd_megakernel, hipFuncAttributeMaxDynamicSharedMemorySize, LDS_BYTES);
        hipOccupancyMaxActiveBlocksPerMultiprocessor(&per_cu, (const void*)fwd_megakernel, 512, LDS_BYTES);
        if (per_cu < 1) { fprintf(stderr, "kernel_launch: occupancy query returned %d\n", per_cu); per_cu = 1; }
        grid = cus * 1;
        (void)hipGetLastError();
    }
    if (grid < 0) return;
    if (hipMemsetAsync((char*)d_ws + WS_BAR, 0, 16384, stream) != hipSuccess) { fprintf(stderr, "kernel_launch: memset of the barrier words failed\n"); return; }
    Params p{};
    const float** f = (const float**)&p;
    for (int i = 0; i < 26; ++i) f[i] = (const float*)d_in[i];
    p.out = (float*)d_out; p.ws = (unsigned char*)d_ws; p.ph_lo = 0; p.ph_hi = N_PHASES;
    void* args[] = {&p};
    hipError_t e = hipLaunchCooperativeKernel((const void*)fwd_megakernel, dim3(grid), dim3(512), args, LDS_BYTES, stream);
    if (e != hipSuccess) fprintf(stderr, "cooperative launch failed: %s (grid %d)\n", hipGetErrorString(e), grid);
}
```

```cpp
#include <hip/hip_runtime.h>
#include <hip/hip_cooperative_groups.h>
#include <cstdio>
#include <cstdint>
namespace cg = cooperative_groups;

#define LAS __attribute__((address_space(3)))
typedef unsigned short bf16_t;
typedef short bf16x8 __attribute__((ext_vector_type(8)));
typedef float f32x4 __attribute__((ext_vector_type(4)));
typedef float f32x2 __attribute__((ext_vector_type(2)));
typedef unsigned u32x4 __attribute__((ext_vector_type(4)));
typedef unsigned u32x2 __attribute__((ext_vector_type(2)));

constexpr int D = 2048, NB = 4, SEQ = 4096, CTX = 256, DFF = 8192;
constexpr int MLAT = NB * SEQ, MCTX = NB * CTX, MALL = MLAT + MCTX;
constexpr int NIN = 4352;
constexpr int C_Q = 0, C_K = 512, C_OG = 1024, C_XR = 2048, C_YR = 3072, C_GL = 4096;
constexpr int NQKV = 6144, NQK = 4096;
constexpr float EPS = 1e-6f;

constexpr size_t MiB = 1u << 20;
constexpr size_t WS_MODV = 0;
constexpr size_t WS_BAR = 544 * 1024;
constexpr size_t WS_ROPE = 512 * 1024;
constexpr size_t WS_WIN = 1 * MiB;
constexpr size_t WS_WV0 = 18 * MiB;
constexpr size_t WS_WOUT = 22 * MiB;
constexpr size_t WS_WUP = 30 * MiB;
constexpr size_t WS_WDN = 94 * MiB;
constexpr size_t WS_WQKV = 158 * MiB;
constexpr size_t WS_WNO = 182 * MiB;
constexpr size_t WS_XC = 190 * MiB;
constexpr size_t WS_A = 198 * MiB;
constexpr size_t WS_R = 266 * MiB;
constexpr size_t WS_P = WS_R;
constexpr size_t WS_VT = WS_R + 146 * MiB;
constexpr size_t WS_OF = WS_R + 214 * MiB;
constexpr size_t WS_OB = WS_R + 282 * MiB;
constexpr size_t WS_HF = WS_R + 350 * MiB;
constexpr size_t WS_HB = WS_R + 384 * MiB;
constexpr size_t WS_GQ = WS_A, WS_GK = WS_A + 34 * MiB;
constexpr size_t WS_GATT = WS_R + 418 * MiB, WS_GBLE = WS_R + 435 * MiB;
constexpr size_t WS_PART = WS_R + 300 * MiB;
constexpr size_t WS_H = WS_R;
constexpr size_t WS_LRUW = WS_R + 437 * MiB;
constexpr size_t WS_END = WS_R + 439 * MiB;

constexpr int LDS_BYTES = 147456;

struct Params {
    const float *x, *c, *ctx, *c_ctx, *mod_w, *mod_b, *norm1_g, *norm2_g, *mlp_up, *mlp_down, *ev_w_in, *ev_w_out;
    const float *gate_up, *gate_b, *gla_g, *conv_w, *conv_b, *w_a, *b_a, *w_x, *b_x, *lam, *na_qkv, *na_out, *rel_bias, *fin_g;
    float* out; unsigned char* ws;
    int ph_lo, ph_hi;
};

typedef __bf16 hwbf16x2 __attribute__((ext_vector_type(2)));
__device__ __forceinline__ unsigned f2bf(float f) { return (unsigned)__builtin_bit_cast(unsigned short, (__bf16)f); }
__device__ __forceinline__ unsigned pk2(float lo, float hi) { return __builtin_bit_cast(unsigned, __builtin_convertvector((f32x2){lo, hi}, hwbf16x2)); }
__device__ __forceinline__ float bflo(unsigned w) { return __builtin_bit_cast(float, w << 16); }
__device__ __forceinline__ float bfhi(unsigned w) { return __builtin_bit_cast(float, w & 0xffff0000u); }
__device__ __forceinline__ float bf1(bf16_t v) { return __builtin_bit_cast(float, (unsigned)v << 16); }
__device__ __forceinline__ float wave_sum(float v) {
#pragma unroll
    for (int o = 1; o < 64; o <<= 1) v += __shfl_xor(v, o);
    return v;
}
__device__ __forceinline__ float dpp_ror(float v, const int ctrl) { return v; }
#define ROW_ROR(v, n) __builtin_bit_cast(float, __builtin_amdgcn_update_dpp(0, __builtin_bit_cast(int, (v)), 0x120 + (n), 0xf, 0xf, false))
__device__ __forceinline__ float row16_max(float v) { v = fmaxf(v, ROW_ROR(v, 8)); v = fmaxf(v, ROW_ROR(v, 4)); v = fmaxf(v, ROW_ROR(v, 2)); v = fmaxf(v, ROW_ROR(v, 1)); return v; }
__device__ __forceinline__ float row16_sum(float v) { v += ROW_ROR(v, 8); v += ROW_ROR(v, 4); v += ROW_ROR(v, 2); v += ROW_ROR(v, 1); return v; }
__device__ __forceinline__ float sigmoidf_(float x) { return 1.f / (1.f + __expf(-x)); }
__device__ __forceinline__ float logsigf_(float z) { return fminf(z, 0.f) - __logf(1.f + __expf(-fabsf(z))); }
__device__ __forceinline__ float siluf_(float x) { return x / (1.f + __expf(-x)); }
__device__ __forceinline__ float gelu_tanh(float x) {
    const float u = 0.7978845608028654f * (x + 0.044715f * x * x * x);
    const float t = 1.f - 2.f / (1.f + __expf(2.f * u));
    return 0.5f * x * (1.f + t);
}
__device__ __forceinline__ void unpack8(u32x4 w, float* f) {
    f[0] = bflo(w.x); f[1] = bfhi(w.x); f[2] = bflo(w.y); f[3] = bfhi(w.y); f[4] = bflo(w.z); f[5] = bfhi(w.z); f[6] = bflo(w.w); f[7] = bfhi(w.w);
}
__device__ __forceinline__ bf16x8 as_bf16x8(u32x4 w) { return __builtin_bit_cast(bf16x8, w); }

namespace pg8 {
constexpr int BM = 256, BK = 64, HALF = 128, HTB = HALF * BK * 2, STAGE_BYTES = 8 * HTB, NXCD = 8, WGM = 4;
__host__ __device__ __forceinline__ int lds_byte(int r, int c) { const int st = (r >> 4) * 2 + (c >> 5), rr = r & 15, cc = c & 31, ob = rr * 64 + cc * 2; return st * 1024 + (ob ^ (((ob >> 9) & 1) << 5)); }
__host__ __device__ __forceinline__ void stage_rc(int b, int& R, int& C) { const int st = b / 1024, sb = b % 1024, swz = sb ^ (((sb >> 9) & 1) << 5); R = (st >> 1) * 16 + swz / 64; C = (st & 1) * 32 + (swz % 64) / 2; }
__host__ __device__ __forceinline__ int perm32(int rho) { const int n = rho >> 4, i = rho & 15; return 8 * (i >> 2) + 4 * n + (i & 3); }
struct Unit { const char* a; const char* b; int nt, pm, pn, mode, ksi; };
struct Gemm { int ld; };
struct Seg { const char* a; const char* b; int nM, nN, ks, nt, mode, count; };
struct SegOrder {
    Seg s0, s1; int nseg, G, c; size_t tstep;
    __device__ __forceinline__ void init(int ld, int G_, int c_) { G = G_; c = c_; tstep = (size_t)BM * ld * 2; nseg = 0; s1.count = 0; }
    __device__ __forceinline__ void add(const void* a, const void* b, int nM, int nN, int ks, int nt, int mode) {
        Seg q; q.a = (const char*)a; q.b = (const char*)b; q.nM = nM; q.nN = nN; q.ks = ks; q.nt = nt; q.mode = mode; q.count = nM * nN * ks;
        if (nseg == 0) s0 = q; else s1 = q; ++nseg; }
    __device__ __forceinline__ bool next(int i, Unit& u) const {
        long L = (long)i * G + c; bool second = false;
        if (L >= s0.count) { L -= s0.count; second = true; if (L >= s1.count) return false; }
        const char* qa = second ? s1.a : s0.a; const char* qb = second ? s1.b : s0.b;
        const int nM = second ? s1.nM : s0.nM, nN = second ? s1.nN : s0.nN, ks = second ? s1.ks : s0.ks, qnt = second ? s1.nt : s0.nt, mode = second ? s1.mode : s0.mode;
        const int ksi = (int)(L % ks); int wgid = (int)(L / ks); const int nwg = nM * nN;
        { const int qq = nwg / NXCD, r = nwg % NXCD, xcd = wgid % NXCD, off = wgid / NXCD; wgid = (xcd < r ? xcd * (qq + 1) : r * (qq + 1) + (xcd - r) * qq) + off; }
        const int nig = WGM * nN, gid = wgid / nig, fm = gid * WGM, gsz = (nM - fm) < WGM ? (nM - fm) : WGM;
        u.pm = fm + ((wgid % nig) % gsz); u.pn = (wgid % nig) / gsz; u.nt = qnt; u.mode = mode; u.ksi = ksi;
        const size_t koff = (size_t)ksi * qnt * (BK * 2);
        u.a = qa + (size_t)u.pm * tstep + koff; u.b = qb + (size_t)u.pn * tstep + koff; return true;
    }
    __device__ __forceinline__ void a_ready(const Unit&) const {}
    __device__ __forceinline__ void done(const Unit&) const {}
};
__device__ __forceinline__ unsigned cvt_pk_bf16(float lo, float hi) { return pk2(lo, hi); }

struct EpiBf16 {
    static constexpr bool PERM = true, AFTER_DRAIN = false;
    bf16_t* O0; int ldc0; bf16_t* O1; int ldc1; int ACT;
    __device__ __forceinline__ void operator()(const f32x4 (&acc)[2][2][4][2], const Unit& u, int wr, int wc, int fr, int fq) const {
        const int row0 = u.pm * BM + wr * 64 + fr; const int col0 = u.pn * BM + wc * 32 + 8 * fq;
        bf16_t* O = u.mode ? O1 : O0; const int ldc = u.mode ? ldc1 : ldc0;
#pragma unroll
        for (int ai = 0; ai < 2; ++ai)
#pragma unroll
            for (int m = 0; m < 4; ++m) { bf16_t* rowp = O + (size_t)(row0 + ai * HALF + m * 16) * ldc + col0;
#pragma unroll
                for (int bj = 0; bj < 2; ++bj) { f32x4 v0 = acc[ai][bj][m][0], v1 = acc[ai][bj][m][1];
                    if (ACT == 1) {
#pragma unroll
                        for (int e = 0; e < 4; ++e) { float a = fmaxf(v0[e], 0.f), b = fmaxf(v1[e], 0.f); v0[e] = a * a; v1[e] = b * b; } }
                    u32x4 w; w.x = cvt_pk_bf16(v0[0], v0[1]); w.y = cvt_pk_bf16(v0[2], v0[3]); w.z = cvt_pk_bf16(v1[0], v1[1]); w.w = cvt_pk_bf16(v1[2], v1[3]);
                    *(u32x4*)(rowp + bj * HALF) = w; } }
    }
};
struct EpiResid {
    static constexpr bool PERM = false, AFTER_DRAIN = false;
    const float* base_lat; float* out_lat; float* out_ctx; const float* gate;
    __device__ __forceinline__ void operator()(const f32x4 (&acc)[2][2][4][2], const Unit& u, int wr, int wc, int fr, int fq) const {
        const bool isl = u.mode == 0;
        const int bidx = isl ? (u.pm >> 4) : 4;
        const float* gp = gate + (size_t)bidx * (6 * D) + u.pn * BM + wc * 32 + 4 * fq;
        const size_t eoff = ((size_t)u.pm * BM + wr * 64 + fr) * D + u.pn * BM + wc * 32 + 4 * fq;
        f32x4 gv[2][2];
#pragma unroll
        for (int bj = 0; bj < 2; ++bj)
#pragma unroll
            for (int n = 0; n < 2; ++n) gv[bj][n] = *(const f32x4*)(gp + bj * HALF + n * 16);
        if (isl) {
            const float* bp = base_lat + eoff; float* op = out_lat + eoff;
#pragma unroll
            for (int ai = 0; ai < 2; ++ai) {
                f32x4 bs[4][2][2];
#pragma unroll
                for (int m = 0; m < 4; ++m)
#pragma unroll
                    for (int bj = 0; bj < 2; ++bj)
#pragma unroll
                        for (int n = 0; n < 2; ++n) bs[m][bj][n] = *(const f32x4*)(bp + (size_t)(ai * HALF + m * 16) * D + bj * HALF + n * 16);
                asm volatile("" ::: "memory");
#pragma unroll
                for (int m = 0; m < 4; ++m)
#pragma unroll
                    for (int bj = 0; bj < 2; ++bj)
#pragma unroll
                        for (int n = 0; n < 2; ++n) *(f32x4*)(op + (size_t)(ai * HALF + m * 16) * D + bj * HALF + n * 16) = bs[m][bj][n] + gv[bj][n] * acc[ai][bj][m][n];
                asm volatile("" ::: "memory");
            }
        } else {
            float* op = out_ctx + (size_t)u.ksi * MCTX * D + eoff;
#pragma unroll
            for (int ai = 0; ai < 2; ++ai)
#pragma unroll
                for (int m = 0; m < 4; ++m) { const size_t off = (size_t)(ai * HALF + m * 16) * D;
#pragma unroll
                    for (int bj = 0; bj < 2; ++bj)
#pragma unroll
                        for (int n = 0; n < 2; ++n) *(f32x4*)(op + off + bj * HALF + n * 16) = acc[ai][bj][m][n]; }
        }
    }
};

template <class Epi, class Sched, bool ALIGN_EPI = false, bool SP2 = false>
__device__ __forceinline__ void gemm_phase(LAS unsigned char* lds, const Gemm g, const Sched& S, const Epi& E) {
    const int tid = threadIdx.x, wid = __builtin_amdgcn_readfirstlane(tid >> 6), lane = tid & 63, wr = wid >> 2, wc = wid & 3, fr = lane & 15, fq = lane >> 4;
    const int K = g.ld;
    unsigned voffA[2], voffB[2];
#pragma unroll
    for (int i = 0; i < 2; ++i) { int R, C; stage_rc(tid * 16 + i * 8192, R, C); const int Rb = Epi::PERM ? ((R & ~31) + perm32(R & 31)) : R;
        voffA[i] = (unsigned)(R * K + C) * 2u; voffB[i] = (unsigned)(Rb * K + C) * 2u; }
    const size_t kstep = (size_t)(BK * 2);
    const size_t hstep = (size_t)HALF * K * 2;
    const unsigned ldsw = (unsigned)wid * 1024u;
    const int aoff = lds_byte(wr * 64 + fr, fq * 8), boff = lds_byte(wc * 32 + fr, fq * 8);
#define PG8_SA(b, h) (((b) * 2 + (h)) * HTB)
#define PG8_SB(b, h) ((4 + (b) * 2 + (h)) * HTB)
#define PG8_STAGE(bufoff, gbase, voff) do { _Pragma("unroll") for (int _i = 0; _i < 2; ++_i) \
        __builtin_amdgcn_global_load_lds((const unsigned*)((const char*)(gbase) + (voff)[_i]), (LAS unsigned*)(lds + (bufoff) + ldsw + _i * 8192), 16, 0, 0); } while (0)
#define PG8_LDA(dst, b, h) do { _Pragma("unroll") for (int m = 0; m < 4; ++m) _Pragma("unroll") for (int k = 0; k < 2; ++k) dst[m][k] = *(const LAS bf16x8*)(lds + PG8_SA(b, h) + aoff + m * 2048 + k * 1024); } while (0)
#define PG8_LDB(dst, b, h) do { _Pragma("unroll") for (int n = 0; n < 2; ++n) _Pragma("unroll") for (int k = 0; k < 2; ++k) dst[n][k] = *(const LAS bf16x8*)(lds + PG8_SB(b, h) + boff + n * 2048 + k * 1024); } while (0)
#define PG8_MMA(ai, bj, At, Bt) do { __builtin_amdgcn_s_setprio(1); _Pragma("unroll") for (int m = 0; m < 4; ++m) _Pragma("unroll") for (int n = 0; n < 2; ++n) _Pragma("unroll") for (int k = 0; k < 2; ++k) \
        acc[ai][bj][m][n] = __builtin_amdgcn_mfma_f32_16x16x32_bf16(Bt[n][k], At[m][k], acc[ai][bj][m][n], 0, 0, 0); __builtin_amdgcn_s_setprio(0); } while (0)
#define PG8_WAIT_V(n) asm volatile("s_waitcnt vmcnt(" #n ")" ::: "memory")
#define PG8_WAIT_L(n) asm volatile("s_waitcnt lgkmcnt(" #n ")" ::: "memory")
#define PG8_BAR __builtin_amdgcn_s_barrier()
#define PG8_SCHED __builtin_amdgcn_sched_barrier(0)
    Unit cur, nxt; int ui = 0;
    if (!S.next(0, cur)) return;
    f32x4 acc[2][2][4][2];
#pragma unroll
    for (int a = 0; a < 2; ++a)
#pragma unroll
        for (int b = 0; b < 2; ++b)
#pragma unroll
            for (int m = 0; m < 4; ++m)
#pragma unroll
                for (int n = 0; n < 2; ++n) acc[a][b][m][n] = (f32x4){0.f, 0.f, 0.f, 0.f};
    bf16x8 At[4][2], B0[2][2], B1[2][2];
    const char* cA = cur.a; const char* cB = cur.b;
    S.a_ready(cur);
    if constexpr (SP2) {
        PG8_STAGE(PG8_SB(0, 0), cB, voffB); PG8_STAGE(PG8_SB(0, 1), cB + hstep, voffB); PG8_STAGE(PG8_SA(0, 0), cA, voffA); PG8_STAGE(PG8_SA(0, 1), cA + hstep, voffA);
        if (wr == 1) PG8_BAR;
        PG8_WAIT_V(2); PG8_BAR;
        PG8_STAGE(PG8_SB(1, 0), cB + kstep, voffB); PG8_STAGE(PG8_SA(1, 0), cA + kstep, voffA); PG8_STAGE(PG8_SB(1, 1), cB + hstep + kstep, voffB);
        PG8_WAIT_V(6); PG8_BAR;
    } else {
        PG8_STAGE(PG8_SB(0, 0), cB, voffB); PG8_STAGE(PG8_SA(0, 0), cA, voffA); PG8_STAGE(PG8_SB(0, 1), cB + hstep, voffB); PG8_STAGE(PG8_SA(0, 1), cA + hstep, voffA);
        if (wr == 1) PG8_BAR;
        PG8_WAIT_V(4); PG8_BAR;
        PG8_STAGE(PG8_SB(1, 0), cB + kstep, voffB); PG8_STAGE(PG8_SA(1, 0), cA + kstep, voffA); PG8_STAGE(PG8_SB(1, 1), cB + hstep + kstep, voffB);
        PG8_WAIT_V(6); PG8_BAR;
    }
    for (;;) {
        const bool has_next = S.next(ui + 1, nxt);
        const char* nA = has_next ? nxt.a : cA; const char* nB = has_next ? nxt.b : cB;
        const int nt = cur.nt;
        for (int t = 0; t < nt; t += 2) {
            const bool last = (t == nt - 2);
            const char* a1 = cA + (size_t)(t + 1) * kstep;
            const char* a2 = last ? nA : cA + (size_t)(t + 2) * kstep; const char* b2 = last ? nB : cB + (size_t)(t + 2) * kstep;
            const char* a3 = a2 + kstep; const char* b3 = b2 + kstep;
            if (last && has_next) S.a_ready(nxt);
            if constexpr (SP2) {
            PG8_LDB(B0, 0, 0); PG8_LDB(B1, 0, 1); PG8_SCHED; PG8_LDA(At, 0, 0); PG8_STAGE(PG8_SA(1, 1), a1 + hstep, voffA);
            PG8_WAIT_V(8); PG8_WAIT_L(0); PG8_BAR; PG8_MMA(0, 0, At, B0); PG8_MMA(0, 1, At, B1); PG8_BAR; PG8_SCHED;
            PG8_LDA(At, 0, 1); PG8_STAGE(PG8_SB(0, 0), b2, voffB); PG8_STAGE(PG8_SB(0, 1), b2 + hstep, voffB); PG8_STAGE(PG8_SA(0, 0), a2, voffA);
            PG8_WAIT_V(8); PG8_WAIT_L(0); PG8_BAR; PG8_MMA(1, 0, At, B0); PG8_MMA(1, 1, At, B1); PG8_BAR; PG8_SCHED;
            PG8_LDB(B0, 1, 0); PG8_LDB(B1, 1, 1); PG8_SCHED; PG8_LDA(At, 1, 0); PG8_STAGE(PG8_SA(0, 1), a2 + hstep, voffA);
            PG8_WAIT_V(8); PG8_WAIT_L(0); PG8_BAR; PG8_MMA(0, 0, At, B0); PG8_MMA(0, 1, At, B1); PG8_BAR; PG8_SCHED;
            PG8_LDA(At, 1, 1); PG8_STAGE(PG8_SB(1, 0), b3, voffB); PG8_STAGE(PG8_SB(1, 1), b3 + hstep, voffB); PG8_STAGE(PG8_SA(1, 0), a3, voffA);
            PG8_WAIT_V(8); PG8_WAIT_L(0); PG8_BAR; PG8_MMA(1, 0, At, B0); PG8_MMA(1, 1, At, B1); PG8_BAR; PG8_SCHED;
            } else {
            PG8_LDB(B0, 0, 0); PG8_SCHED; PG8_LDA(At, 0, 0); PG8_STAGE(PG8_SA(1, 1), a1 + hstep, voffA);
            PG8_WAIT_L(8); PG8_BAR; PG8_WAIT_L(0); PG8_MMA(0, 0, At, B0); PG8_BAR; PG8_SCHED;
            PG8_LDB(B1, 0, 1); PG8_STAGE(PG8_SB(0, 0), b2, voffB);
            PG8_BAR; PG8_WAIT_L(0); PG8_MMA(0, 1, At, B1); PG8_BAR;
            PG8_LDA(At, 0, 1); PG8_STAGE(PG8_SA(0, 0), a2, voffA);
            PG8_BAR; PG8_WAIT_L(0); PG8_MMA(1, 0, At, B0); PG8_BAR; PG8_SCHED;
            PG8_STAGE(PG8_SB(0, 1), b2 + hstep, voffB);
            PG8_WAIT_V(6); PG8_BAR; PG8_MMA(1, 1, At, B1); PG8_BAR;
            PG8_LDB(B0, 1, 0); PG8_SCHED; PG8_LDA(At, 1, 0); PG8_STAGE(PG8_SA(0, 1), a2 + hstep, voffA);
            PG8_WAIT_L(8); PG8_BAR; PG8_WAIT_L(0); PG8_MMA(0, 0, At, B0); PG8_BAR; PG8_SCHED;
            PG8_LDB(B1, 1, 1); PG8_STAGE(PG8_SB(1, 0), b3, voffB);
            PG8_BAR; PG8_WAIT_L(0); PG8_MMA(0, 1, At, B1); PG8_BAR;
            PG8_LDA(At, 1, 1); PG8_STAGE(PG8_SA(1, 0), a3, voffA);
            PG8_BAR; PG8_WAIT_L(0); PG8_MMA(1, 0, At, B0); PG8_BAR; PG8_SCHED;
            PG8_STAGE(PG8_SB(1, 1), b3 + hstep, voffB);
            PG8_WAIT_V(6); PG8_BAR; PG8_MMA(1, 1, At, B1); PG8_BAR;
            }
        }
        if constexpr (ALIGN_EPI) { if (wr == 0) PG8_BAR; }
        if constexpr (!Epi::AFTER_DRAIN) { E(acc, cur, wr, wc, fr, fq); S.done(cur); }
        if (!has_next) break;
#pragma unroll
        for (int a = 0; a < 2; ++a)
#pragma unroll
            for (int b = 0; b < 2; ++b)
#pragma unroll
                for (int m = 0; m < 4; ++m)
#pragma unroll
                    for (int n = 0; n < 2; ++n) acc[a][b][m][n] = (f32x4){0.f, 0.f, 0.f, 0.f};
        cur = nxt; cA = nA; cB = nB; ++ui;
        if constexpr (ALIGN_EPI) { if (wr == 1) PG8_BAR; }
    }
    PG8_WAIT_V(0);
    if constexpr (!ALIGN_EPI) { if (wr == 0) PG8_BAR; }
    PG8_BAR;
#undef PG8_SA
#undef PG8_SB
#undef PG8_STAGE
#undef PG8_LDA
#undef PG8_LDB
#undef PG8_MMA
#undef PG8_WAIT_V
#undef PG8_WAIT_L
#undef PG8_BAR
#undef PG8_SCHED
}
}

__device__ __forceinline__ void phase_mod(const Params& p, unsigned char* lds, const int layer, const int wb0, const int nwb) {
    const int tid = threadIdx.x;
    float* sc = (float*)lds;
    float* red = (float*)(lds + 40960);
    float* modv = (float*)(p.ws + WS_MODV);
    __syncthreads();
    for (int e = tid; e < 5 * D; e += 512) { const int r = e / D, k = e % D; const float v = r < 4 ? p.c[r * D + k] : p.c_ctx[k]; sc[e] = siluf_(v); }
    __syncthreads();
    for (int it = (int)blockIdx.x - wb0; it < 256; it += nwb) {
        const int l = layer, n0 = it * 48;
        const int kg = tid / 12, cg_ = tid % 12;
        float acc[5][4];
#pragma unroll
        for (int r = 0; r < 5; ++r)
#pragma unroll
            for (int j = 0; j < 4; ++j) acc[r][j] = 0.f;
        if (kg < 42) {
            const float* wp = p.mod_w + (size_t)l * D * (6 * D) + n0 + 4 * cg_;
#pragma unroll 4
            for (int k = kg; k < D; k += 42) {
                const f32x4 w = *(const f32x4*)(wp + (size_t)k * (6 * D));
#pragma unroll
                for (int r = 0; r < 5; ++r) { const float s = sc[r * D + k];
#pragma unroll
                    for (int j = 0; j < 4; ++j) acc[r][j] += s * w[j]; }
            }
#pragma unroll
            for (int r = 0; r < 5; ++r)
#pragma unroll
                for (int j = 0; j < 4; ++j) red[(kg * 5 + r) * 48 + 4 * cg_ + j] = acc[r][j];
        }
        __syncthreads();
        if (tid < 240) { const int r = tid / 48, n = tid % 48; float s = p.mod_b[l * (6 * D) + n0 + n];
            for (int q = 0; q < 42; ++q) s += red[(q * 5 + r) * 48 + n];
            modv[((size_t)l * 5 + r) * (6 * D) + n0 + n] = s; }
        __syncthreads();
    }
    if (layer == 0 && blockIdx.x == gridDim.x - 1) {
        f32x2* tab = (f32x2*)(p.ws + WS_ROPE);
        for (int e = tid; e < 64 * 32; e += 512) { const int pos = e >> 5, i = e & 31;
            const float inv = exp2f(-(float)i * (13.287712379549449f / 32.f));
            const float ang = (float)pos * inv;
            tab[e] = (f32x2){__cosf(ang), __sinf(ang)}; }
    }
}

__device__ __forceinline__ void transpose_item(const float* W, int K, int N, bf16_t* WT, int kb, int n0, int dst_n0, float* scr, int lane) {
    const int k0 = 64 * kb;
    float wv[32];
#pragma unroll
    for (int i = 0; i < 32; ++i) wv[i] = W[(size_t)(k0 + 2 * i + (lane >> 5)) * N + n0 + (lane & 31)];
#pragma unroll
    for (int i = 0; i < 32; ++i) scr[(2 * i + (lane >> 5)) * 33 + (lane & 31)] = wv[i];
    asm volatile("s_waitcnt lgkmcnt(0)" ::: "memory");
    const int c = lane & 7;
#pragma unroll
    for (int j = 0; j < 4; ++j) { const int n = (lane >> 3) + 8 * j; const float* s = scr + (8 * c) * 33 + n;
        u32x4 o; o.x = pk2(s[0 * 33], s[1 * 33]); o.y = pk2(s[2 * 33], s[3 * 33]); o.z = pk2(s[4 * 33], s[5 * 33]); o.w = pk2(s[6 * 33], s[7 * 33]);
        *(u32x4*)(WT + (size_t)(dst_n0 + n) * K + k0 + 8 * c) = o; }
    asm volatile("s_waitcnt lgkmcnt(0)" ::: "memory");
}
__device__ __forceinline__ void modulate_row(const float* xr, const float* g, const float* shift, const float* scale, bf16_t* dst, int lane, const float* part, const float* cgate, float* xw) {
    f32x4 v[8]; float ss = 0.f;
#pragma unroll
    for (int j = 0; j < 8; ++j) { const int c = 256 * j + 4 * lane; v[j] = *(const f32x4*)(xr + c);
        if (part) { f32x4 a = *(const f32x4*)(part + c);
#pragma unroll
            for (int sp = 1; sp < 8; ++sp) a += *(const f32x4*)(part + (size_t)sp * MCTX * D + c);
            v[j] += *(const f32x4*)(cgate + c) * a; *(f32x4*)(xw + c) = v[j]; }
        ss += (v[j].x * v[j].x + v[j].y * v[j].y) + (v[j].z * v[j].z + v[j].w * v[j].w); }
    const float rstd = rsqrtf(wave_sum(ss) * (1.f / D) + EPS);
#pragma unroll
    for (int j = 0; j < 8; ++j) { const int c = 256 * j + 4 * lane;
        const f32x4 gg = *(const f32x4*)(g + c), sh = *(const f32x4*)(shift + c), sc = *(const f32x4*)(scale + c);
        const f32x4 o = v[j] * rstd * gg * (sc + 1.f) + sh;
        u32x2 w; w.x = pk2(o.x, o.y); w.y = pk2(o.z, o.w); *(u32x2*)(dst + c) = w; }
}
__device__ __forceinline__ void modulate_rows2(const float* x0, const float* x1, const float* g, const float* mv0, const float* mv1, bf16_t* d0, bf16_t* d1, int lane) {
    f32x4 v0[8], v1[8]; float s0 = 0.f, s1 = 0.f;
#pragma unroll
    for (int j = 0; j < 8; ++j) { v0[j] = *(const f32x4*)(x0 + 256 * j + 4 * lane); v1[j] = *(const f32x4*)(x1 + 256 * j + 4 * lane); }
#pragma unroll
    for (int j = 0; j < 8; ++j) { s0 += (v0[j].x * v0[j].x + v0[j].y * v0[j].y) + (v0[j].z * v0[j].z + v0[j].w * v0[j].w); s1 += (v1[j].x * v1[j].x + v1[j].y * v1[j].y) + (v1[j].z * v1[j].z + v1[j].w * v1[j].w); }
    const float r0 = rsqrtf(wave_sum(s0) * (1.f / D) + EPS), r1 = rsqrtf(wave_sum(s1) * (1.f / D) + EPS);
#pragma unroll
    for (int j = 0; j < 8; ++j) { const int c = 256 * j + 4 * lane;
        const f32x4 gg = *(const f32x4*)(g + c);
        const f32x4 o0 = v0[j] * r0 * gg * (*(const f32x4*)(mv0 + D + c) + 1.f) + *(const f32x4*)(mv0 + c);
        const f32x4 o1 = v1[j] * r1 * gg * (*(const f32x4*)(mv1 + D + c) + 1.f) + *(const f32x4*)(mv1 + c);
        *(u32x2*)(d0 + c) = (u32x2){pk2(o0.x, o0.y), pk2(o0.z, o0.w)}; *(u32x2*)(d1 + c) = (u32x2){pk2(o1.x, o1.y), pk2(o1.z, o1.w)}; }
}
__device__ __forceinline__ void phase_modulate(const Params& p, const float* xl, const float* xc, const float* g, int layer, int which, int nrows, int cslot, int clayer) {
    const int lane = threadIdx.x & 63, gw = blockIdx.x * 8 + (threadIdx.x >> 6), NGW = gridDim.x * 8;
    const float* modv = (const float*)(p.ws + WS_MODV) + (size_t)layer * 5 * (6 * D);
    const float* cgate = (const float*)(p.ws + WS_MODV) + ((size_t)clayer * 5 + 4) * (6 * D) + (cslot < 0 ? 0 : cslot) * D;
    bf16_t* A = (bf16_t*)(p.ws + WS_A);
    int m = gw;
    for (; m + NGW < MLAT && m + NGW < nrows; m += 2 * NGW) {
        const int m1 = m + NGW;
        const float* mv0 = modv + (size_t)(m >> 12) * (6 * D) + which * 3 * D; const float* mv1 = modv + (size_t)(m1 >> 12) * (6 * D) + which * 3 * D;
        modulate_rows2(xl + (size_t)m * D, xl + (size_t)m1 * D, g, mv0, mv1, A + (size_t)m * D, A + (size_t)m1 * D, lane);
    }
    for (; m < nrows; m += NGW) {
        const bool isl = m < MLAT; const int bidx = isl ? (m >> 12) : 4;
        const float* xr = isl ? xl + (size_t)m * D : xc + (size_t)(m - MLAT) * D;
        const float* mv = modv + (size_t)bidx * (6 * D) + which * 3 * D;
        const float* part = (!isl && cslot >= 0) ? (const float*)(p.ws + WS_PART) + (size_t)(m - MLAT) * D : nullptr;
        float* xw = (float*)(p.ws + WS_XC) + (size_t)(isl ? 0 : m - MLAT) * D;
        modulate_row(xr, g, mv, mv + D, A + (size_t)m * D, lane, part, cgate, xw);
    }
}
__device__ __forceinline__ void phase_convert(const Params& p, unsigned char* lds, const int part, const int wb0, const int nwb) {
    const int lane = threadIdx.x & 63, wave = threadIdx.x >> 6;
    float* scr = (float*)(lds + wave * 16384);
    const int gw = ((int)blockIdx.x - wb0) * 8 + wave, NGW = nwb * 8;
    constexpr int I_IN = 32 * 161, I_OUT = 32 * 64, I_UP = 32 * 256, I_DN = 128 * 64, I_QKV = 32 * 192, I_NO = 32 * 64;
    bf16_t* win = (bf16_t*)(p.ws + WS_WIN); bf16_t* wout = (bf16_t*)(p.ws + WS_WOUT); bf16_t* wup = (bf16_t*)(p.ws + WS_WUP);
    bf16_t* wdn = (bf16_t*)(p.ws + WS_WDN); bf16_t* wqkv = (bf16_t*)(p.ws + WS_WQKV); bf16_t* wno = (bf16_t*)(p.ws + WS_WNO);
    __syncthreads();
    if (part == 0) {
        for (int it = gw; it < I_IN + I_OUT + I_UP + I_DN; it += NGW) {
            int r = it;
            if (r < I_IN) { const int kb = r / 161, nb = r % 161, n0 = 32 * nb;
                if (n0 >= 1024 && n0 < 2048) { transpose_item(p.ev_w_in, D, 5152, (bf16_t*)(p.ws + WS_WV0), kb, n0, n0 - 1024, scr, lane); continue; }
                const int dn = n0 < 1024 ? n0 : (n0 < 3072 ? n0 - 1024 : (n0 == 3072 ? C_GL : (n0 < 4128 ? n0 - 3104 + C_XR : n0 - 4128 + C_YR)));
                transpose_item(p.ev_w_in, D, 5152, win, kb, n0, dn, scr, lane); continue; } r -= I_IN;
            if (r < I_OUT) { transpose_item(p.ev_w_out, D, D, wout, r / 64, 32 * (r % 64), 32 * (r % 64), scr, lane); continue; } r -= I_OUT;
            if (r < I_UP) { transpose_item(p.mlp_up, D, DFF, wup, r / 256, 32 * (r % 256), 32 * (r % 256), scr, lane); continue; } r -= I_UP;
            transpose_item(p.mlp_down, DFF, D, wdn, r / 64, 32 * (r % 64), 32 * (r % 64), scr, lane);
        }
        for (int m = (int)blockIdx.x - wb0; m < 32; m += nwb) { const float* src = ((m & 1) ? p.w_x : p.w_a) + (size_t)(m >> 1) * 16384; bf16_t* img = (bf16_t*)(p.ws + WS_LRUW) + (size_t)m * (128 * 136);
            for (int e = threadIdx.x; e < 16384; e += 512) { const int ii = e >> 7, j = e & 127; img[j * 136 + ii] = (bf16_t)f2bf(src[e]); }
            for (int e = threadIdx.x; e < 128 * 8; e += 512) img[(e >> 3) * 136 + 128 + (e & 7)] = (bf16_t)0; }
        u32x4* z = (u32x4*)(win + (size_t)4128 * D); const int nz = (NIN - 4128) * D * 2 / 16;
        for (int e = ((int)blockIdx.x - wb0) * 512 + threadIdx.x; e < nz; e += nwb * 512) z[e] = (u32x4){0u, 0u, 0u, 0u};
    } else {
        for (int it = gw; it < I_UP + I_DN + I_QKV + I_NO; it += NGW) {
            int r = it;
            if (r < I_UP) { transpose_item(p.mlp_up + (size_t)D * DFF, D, DFF, wup + (size_t)D * DFF, r / 256, 32 * (r % 256), 32 * (r % 256), scr, lane); continue; } r -= I_UP;
            if (r < I_DN) { transpose_item(p.mlp_down + (size_t)D * DFF, DFF, D, wdn + (size_t)D * DFF, r / 64, 32 * (r % 64), 32 * (r % 64), scr, lane); continue; } r -= I_DN;
            if (r < I_QKV) { transpose_item(p.na_qkv, D, NQKV, wqkv, r / 192, 32 * (r % 192), 32 * (r % 192), scr, lane); continue; } r -= I_QKV;
            transpose_item(p.na_out, D, D, wno, r / 64, 32 * (r % 64), 32 * (r % 64), scr, lane);
        }
    }
    __syncthreads();
}

constexpr int GL_GU = 0, GL_GB = 8192, GL_TAB = 8704, GL_GBUF = 25088, GL_TOT = 58880, GL_BLE = 60928, GL_QE = 61440, GL_KE = 78848, GL_VT = 96256, GL_ATT = 105472, GL_ST = 114688, GL_END = 132096;
static_assert(GL_END <= LDS_BYTES, "gla lds");
#define GLA_ROW(ci, ii, row, tok, isl) do { isl = (ci) >= 4; const int cc_ = isl ? (ci) - 4 : (ci); const int n_ = isl ? SEQ : CTX; const int pos_ = cc_ * 64 + (ii); \
        tok = dir ? n_ - 1 - pos_ : pos_; row = isl ? (size_t)b * SEQ + tok : (size_t)MLAT + b * CTX + tok; } while (0)
__device__ __forceinline__ void gla_pre(const Params& p, unsigned char* lds) {
    const int tid = threadIdx.x, lane = tid & 63, w = __builtin_amdgcn_readfirstlane(tid >> 6);
    float* gu = (float*)(lds + GL_GU); float* gbv = (float*)(lds + GL_GB); f32x2* tab = (f32x2*)(lds + GL_TAB);
    float* gbuf = (float*)(lds + GL_GBUF); float* tot = (float*)(lds + GL_TOT);
    bf16_t* qe = (bf16_t*)(lds + GL_QE); bf16_t* ke = (bf16_t*)(lds + GL_KE); bf16_t* att = (bf16_t*)(lds + GL_ATT);
    const bf16_t* P = (const bf16_t*)(p.ws + WS_P);
    bf16_t* GQ = (bf16_t*)(p.ws + WS_GQ); bf16_t* GK = (bf16_t*)(p.ws + WS_GK); bf16_t* GA = (bf16_t*)(p.ws + WS_GATT); float* GE = (float*)(p.ws + WS_GBLE);
    const int i = tid >> 3, dg = tid & 7;
    const int fr = lane & 15, fq = lane >> 4;
    __syncthreads();
    { const f32x2* rt = (const f32x2*)(p.ws + WS_ROPE); for (int e = tid; e < 2048; e += 512) tab[e] = rt[e]; }
    for (int it = blockIdx.x; it < 32 * 68; it += gridDim.x) {
        const int chain = it / 68, ci = it % 68; const int dir = chain & 1, h = (chain >> 1) & 3, b = chain >> 3;
        __syncthreads();
        for (int e = tid; e < 2048; e += 512) { const int r = e >> 7, d = e & 127; gu[e] = p.gate_up[(dir * 16 + r) * 512 + h * 128 + d]; }
        if (tid < 128) gbv[tid] = p.gate_b[dir * 512 + h * 128 + tid];
        bool isl; int tok; size_t row; GLA_ROW(ci, i, row, tok, isl);
        const bf16_t* pr = P + row * NIN;
        const u32x4 rq0 = *(const u32x4*)(pr + C_Q + h * 128 + dg * 16), rq1 = *(const u32x4*)(pr + C_Q + h * 128 + dg * 16 + 8);
        const u32x4 rqp0 = *(const u32x4*)(pr + C_Q + h * 128 + (dg ^ 2) * 16), rqp1 = *(const u32x4*)(pr + C_Q + h * 128 + (dg ^ 2) * 16 + 8);
        const u32x4 rk0 = *(const u32x4*)(pr + C_K + h * 128 + dg * 16), rk1 = *(const u32x4*)(pr + C_K + h * 128 + dg * 16 + 8);
        const u32x4 rkp0 = *(const u32x4*)(pr + C_K + h * 128 + (dg ^ 2) * 16), rkp1 = *(const u32x4*)(pr + C_K + h * 128 + (dg ^ 2) * 16 + 8);
        const u32x4 rg0 = *(const u32x4*)(pr + C_GL + dir * 16), rg1 = *(const u32x4*)(pr + C_GL + dir * 16 + 8);
        __syncthreads();
        {
            float gl[16]; unpack8(rg0, gl); unpack8(rg1, gl + 8);
            float z[16];
#pragma unroll
            for (int j = 0; j < 16; ++j) z[j] = gbv[dg * 16 + j];
#pragma unroll
            for (int r = 0; r < 16; ++r) {
#pragma unroll
                for (int j4 = 0; j4 < 4; ++j4) { const f32x4 u4 = *(const f32x4*)(gu + r * 128 + dg * 16 + 4 * j4);
                    z[4 * j4 + 0] += gl[r] * u4.x; z[4 * j4 + 1] += gl[r] * u4.y; z[4 * j4 + 2] += gl[r] * u4.z; z[4 * j4 + 3] += gl[r] * u4.w; }
            }
#pragma unroll
            for (int j4 = 0; j4 < 4; ++j4) { f32x4 o; o.x = logsigf_(z[4 * j4]) * 0.0625f; o.y = logsigf_(z[4 * j4 + 1]) * 0.0625f; o.z = logsigf_(z[4 * j4 + 2]) * 0.0625f; o.w = logsigf_(z[4 * j4 + 3]) * 0.0625f;
                *(f32x4*)(gbuf + i * 132 + dg * 16 + 4 * j4) = o; }
        }
        __syncthreads();
        { const int d = tid & 127, seg = tid >> 7; float run = 0.f;
#pragma unroll
          for (int ii = 0; ii < 16; ++ii) { float* gp = gbuf + (seg * 16 + ii) * 132 + d; run += *gp; *gp = run; }
          tot[seg * 128 + d] = run; }
        __syncthreads();
        {
            const int seg = i >> 4;
            float q[16], qp[16], k[16], kp[16];
            unpack8(rq0, q); unpack8(rq1, q + 8); unpack8(rqp0, qp); unpack8(rqp1, qp + 8);
            unpack8(rk0, k); unpack8(rk1, k + 8); unpack8(rkp0, kp); unpack8(rkp1, kp + 8);
            const float qs = 0.08838834764831845f;
            if (isl) {
                const int posr = (dg < 4) ? (tok >> 6) : (tok & 63);
                const float sgn = (dg & 2) ? 1.f : -1.f;
                const f32x2* tp = tab + posr * 32 + (dg & 1) * 16;
#pragma unroll
                for (int j = 0; j < 16; ++j) { const f32x2 cs = tp[j];
                    q[j] = q[j] * cs.x + sgn * qp[j] * cs.y; k[j] = k[j] * cs.x + sgn * kp[j] * cs.y; }
            }
            unsigned qw[8], kw[8];
#pragma unroll
            for (int j2 = 0; j2 < 8; ++j2) {
                const int d0 = dg * 16 + 2 * j2;
                float b0 = gbuf[i * 132 + d0], b1 = gbuf[i * 132 + d0 + 1];
                if (seg > 0) { b0 += tot[d0]; b1 += tot[d0 + 1]; }
                if (seg > 1) { b0 += tot[128 + d0]; b1 += tot[128 + d0 + 1]; }
                if (seg > 2) { b0 += tot[256 + d0]; b1 += tot[256 + d0 + 1]; }
                const float e0 = __expf(b0), e1 = __expf(b1), n0 = __expf(-b0), n1 = __expf(-b1);
                if (i == 63) { GE[(size_t)it * 128 + d0] = e0; GE[(size_t)it * 128 + d0 + 1] = e1; }
                qw[j2] = pk2(q[2 * j2] * qs * e0, q[2 * j2 + 1] * qs * e1);
                kw[j2] = pk2(k[2 * j2] * n0, k[2 * j2 + 1] * n1);
            }
            const u32x4 q0 = (u32x4){qw[0], qw[1], qw[2], qw[3]}, q1 = (u32x4){qw[4], qw[5], qw[6], qw[7]}, k0 = (u32x4){kw[0], kw[1], kw[2], kw[3]}, k1 = (u32x4){kw[4], kw[5], kw[6], kw[7]};
            *(u32x4*)(qe + i * 136 + dg * 16) = q0; *(u32x4*)(qe + i * 136 + dg * 16 + 8) = q1;
            *(u32x4*)(ke + i * 136 + dg * 16) = k0; *(u32x4*)(ke + i * 136 + dg * 16 + 8) = k1;
            bf16_t* gq = GQ + (size_t)it * 8192 + i * 128 + dg * 16; bf16_t* gk = GK + (size_t)it * 8192 + i * 128 + dg * 16;
            *(u32x4*)gq = q0; *(u32x4*)(gq + 8) = q1; *(u32x4*)gk = k0; *(u32x4*)(gk + 8) = k1;
        }
        __syncthreads();
        {
            const int tr = w >> 1;
#pragma unroll
            for (int c2 = 0; c2 < 2; ++c2) { const int tc = (w & 1) * 2 + c2;
                f32x4 a = (f32x4){0.f, 0.f, 0.f, 0.f};
                if (tc <= tr) {
#pragma unroll
                    for (int ks = 0; ks < 4; ++ks) { const bf16x8 A = *(const bf16x8*)(qe + (tr * 16 + fr) * 136 + ks * 32 + fq * 8); const bf16x8 B = *(const bf16x8*)(ke + (tc * 16 + fr) * 136 + ks * 32 + fq * 8);
                        a = __builtin_amdgcn_mfma_f32_16x16x32_bf16(A, B, a, 0, 0, 0); }
                }
#pragma unroll
                for (int j = 0; j < 4; ++j) { const int t = tr * 16 + fq * 4 + j, s2 = tc * 16 + fr; const float v = (s2 <= t) ? a[j] : 0.f; att[t * 72 + s2] = (bf16_t)f2bf(v); }
            }
        }
        __syncthreads();
        { const int t = tid >> 3, c8 = tid & 7; *(u32x4*)(GA + (size_t)it * 4096 + t * 64 + c8 * 8) = *(const u32x4*)(att + t * 72 + c8 * 8); }
    }
    __syncthreads();
}
__device__ __forceinline__ void gla_seq(const Params& p, unsigned char* lds, int gb) {
    const int tid = threadIdx.x, lane = tid & 63, w = __builtin_amdgcn_readfirstlane(tid >> 6);
    const int dvs = gb & 3, dir = (gb >> 2) & 1, h = (gb >> 3) & 3, b = gb >> 5;
    const int chain = (b * 4 + h) * 2 + dir;
    float* blE = (float*)(lds + GL_BLE); float* ostg = (float*)(lds + GL_GBUF);
    bf16_t* qe = (bf16_t*)(lds + GL_QE); bf16_t* ke = (bf16_t*)(lds + GL_KE); bf16_t* vt = (bf16_t*)(lds + GL_VT);
    bf16_t* att = (bf16_t*)(lds + GL_ATT); bf16_t* St = (bf16_t*)(lds + GL_ST);
    const bf16_t* GQ = (const bf16_t*)(p.ws + WS_GQ) + (size_t)chain * 68 * 8192; const bf16_t* GK = (const bf16_t*)(p.ws + WS_GK) + (size_t)chain * 68 * 8192;
    const bf16_t* GA = (const bf16_t*)(p.ws + WS_GATT) + (size_t)chain * 68 * 4096; const float* GE = (const float*)(p.ws + WS_GBLE) + (size_t)chain * 68 * 128;
    bf16_t* obuf = (bf16_t*)(p.ws + (dir ? WS_OB : WS_OF));
    const int i = tid >> 3, dg = tid & 7;
    const int fr = lane & 15, fq = lane >> 4;
    const bf16_t* VT = (const bf16_t*)(p.ws + WS_VT) + (size_t)(h * 256 + dvs * 64 + i) * MALL;
    __syncthreads();
    for (int e = tid; e < 64 * 136 / 2; e += 512) ((unsigned*)St)[e] = 0u;
    f32x4 S[4];
#pragma unroll
    for (int q = 0; q < 4; ++q) S[q] = (f32x4){0.f, 0.f, 0.f, 0.f};
    u32x4 RA[6], RB[6]; float reA, reB;
#define GS_LOAD(R, re, ci) do { const bf16_t* gq = GQ + (size_t)(ci) * 8192 + i * 128 + dg * 16; const bf16_t* gk = GK + (size_t)(ci) * 8192 + i * 128 + dg * 16; \
        R[0] = *(const u32x4*)gq; R[1] = *(const u32x4*)(gq + 8); R[2] = *(const u32x4*)gk; R[3] = *(const u32x4*)(gk + 8); \
        R[4] = *(const u32x4*)(GA + (size_t)(ci) * 4096 + i * 64 + dg * 8); \
        { const bool isl_ = (ci) >= 4; const int cc2_ = isl_ ? (ci) - 4 : (ci); const int n2_ = isl_ ? SEQ : CTX; const int tlo_ = dir ? n2_ - 64 - cc2_ * 64 : cc2_ * 64; \
          R[5] = *(const u32x4*)(VT + (isl_ ? (size_t)b * SEQ : (size_t)MLAT + b * CTX) + tlo_ + 8 * dg); } \
        re = (tid < 128) ? GE[(size_t)(ci) * 128 + tid] : 0.f; } while (0)
#define GS_BODY(R, re, ci) do { \
        *(u32x4*)(qe + i * 136 + dg * 16) = R[0]; *(u32x4*)(qe + i * 136 + dg * 16 + 8) = R[1]; \
        *(u32x4*)(ke + i * 136 + dg * 16) = R[2]; *(u32x4*)(ke + i * 136 + dg * 16 + 8) = R[3]; \
        *(u32x4*)(att + i * 72 + dg * 8) = R[4]; \
        if (dir == 0) *(u32x4*)(vt + i * 72 + 8 * dg) = R[5]; \
        else { u32x4 o; o.x = (R[5].w >> 16) | (R[5].w << 16); o.y = (R[5].z >> 16) | (R[5].z << 16); o.z = (R[5].y >> 16) | (R[5].y << 16); o.w = (R[5].x >> 16) | (R[5].x << 16); *(u32x4*)(vt + i * 72 + 56 - 8 * dg) = o; } \
        if (tid < 128) blE[tid] = re; \
        if ((ci) + 2 < 68) GS_LOAD(R, re, (ci) + 2); \
        __syncthreads(); \
        { \
            const int tr = w >> 1; \
            _Pragma("unroll") for (int c2 = 0; c2 < 2; ++c2) { const int vc = (w & 1) * 2 + c2; \
                f32x4 a = (f32x4){0.f, 0.f, 0.f, 0.f}; \
                _Pragma("unroll") for (int ks = 0; ks < 4; ++ks) { const bf16x8 A = *(const bf16x8*)(qe + (tr * 16 + fr) * 136 + ks * 32 + fq * 8); const bf16x8 B = *(const bf16x8*)(St + (vc * 16 + fr) * 136 + ks * 32 + fq * 8); \
                    a = __builtin_amdgcn_mfma_f32_16x16x32_bf16(A, B, a, 0, 0, 0); } \
                _Pragma("unroll") for (int ks = 0; ks < 2; ++ks) { const bf16x8 A = *(const bf16x8*)(att + (tr * 16 + fr) * 72 + ks * 32 + fq * 8); const bf16x8 B = *(const bf16x8*)(vt + (vc * 16 + fr) * 72 + ks * 32 + fq * 8); \
                    a = __builtin_amdgcn_mfma_f32_16x16x32_bf16(A, B, a, 0, 0, 0); } \
                _Pragma("unroll") for (int j = 0; j < 4; ++j) ostg[(tr * 16 + fq * 4 + j) * 68 + vc * 16 + fr] = a[j]; \
            } \
            _Pragma("unroll") for (int ks = 0; ks < 2; ++ks) { \
                bf16x8 A; \
                _Pragma("unroll") for (int j = 0; j < 8; ++j) A[j] = (short)ke[(ks * 32 + fq * 8 + j) * 136 + 16 * w + fr]; \
                _Pragma("unroll") for (int vc = 0; vc < 4; ++vc) { const bf16x8 B = *(const bf16x8*)(vt + (vc * 16 + fr) * 72 + ks * 32 + fq * 8); \
                    S[vc] = __builtin_amdgcn_mfma_f32_16x16x32_bf16(A, B, S[vc], 0, 0, 0); } \
            } \
            const f32x4 sc = *(const f32x4*)(blE + 16 * w + fq * 4); \
            _Pragma("unroll") for (int vc = 0; vc < 4; ++vc) S[vc] = S[vc] * sc; \
        } \
        __syncthreads(); \
        _Pragma("unroll") for (int vc = 0; vc < 4; ++vc) { u32x2 o; o.x = pk2(S[vc][0], S[vc][1]); o.y = pk2(S[vc][2], S[vc][3]); *(u32x2*)(St + (vc * 16 + fr) * 136 + 16 * w + fq * 4) = o; } \
        { bool isl2; int tok2; size_t row2; GLA_ROW(ci, i, row2, tok2, isl2);     \
          bf16_t* od = obuf + row2 * 1024 + h * 256 + dvs * 64 + dg * 8; \
          const f32x4 o0_ = *(const f32x4*)(ostg + i * 68 + dg * 8), o1_ = *(const f32x4*)(ostg + i * 68 + dg * 8 + 4); \
          *(u32x4*)od = (u32x4){pk2(o0_[0], o0_[1]), pk2(o0_[2], o0_[3]), pk2(o1_[0], o1_[1]), pk2(o1_[2], o1_[3])}; } \
    } while (0)
    GS_LOAD(RA, reA, 0); GS_LOAD(RB, reB, 1);
    for (int ci = 0; ci < 68; ci += 2) { GS_BODY(RA, reA, ci); GS_BODY(RB, reB, ci + 1); }
    __syncthreads();
#undef GS_LOAD
#undef GS_BODY
}

constexpr int LR_BA = 0, LR_BX = 34816, LR_XCB = 69632, LR_XC32 = 87040, LR_CW = 120832, LR_END = 123392;
static_assert(LR_END <= LDS_BYTES, "lru lds");
constexpr size_t DO_PC0 = 0, DO_PC1 = 34 * MiB, DO_TOT = 68 * MiB;
__device__ __forceinline__ float expm1_neg(float x) {
    return (x > -0.02f) ? x * (1.f + x * (0.5f + x * (0.16666667f + x * 0.041666667f))) : __expf(x) - 1.f;
}
__device__ __forceinline__ void lru_pre(const Params& p, unsigned char* lds) {
    const int tid = threadIdx.x, lane = tid & 63, w = __builtin_amdgcn_readfirstlane(tid >> 6);
    const int dgi = blockIdx.x & 15, sub = blockIdx.x >> 4, nsub = (gridDim.x - dgi + 15) >> 4;
    const int g = dgi & 7, dir = dgi >> 3, c0 = 128 * g;
    bf16_t* Ba = (bf16_t*)(lds + LR_BA); bf16_t* Bx = (bf16_t*)(lds + LR_BX); bf16_t* xcb = (bf16_t*)(lds + LR_XCB);
    float* xc32 = (float*)(lds + LR_XC32); float* cw = (float*)(lds + LR_CW);
    const bf16_t* P = (const bf16_t*)(p.ws + WS_P);
    bf16_t* hbuf = (bf16_t*)(p.ws + (dir ? WS_HB : WS_HF));
    bf16_t* pcbuf = (bf16_t*)((unsigned char*)p.out + (dir ? DO_PC1 : DO_PC0));
    float* totP = (float*)((unsigned char*)p.out + DO_TOT); float* totH = totP + (size_t)8 * 68 * 1024;
    __syncthreads();
    { const u32x4* img = (const u32x4*)(p.ws + WS_LRUW + (size_t)(dir * 8 + g) * 2 * (128 * 136 * 2)); u32x4* dst = (u32x4*)Ba;
      for (int e = tid; e < 2 * 34816 / 16; e += 512) dst[e] = img[e]; }
    for (int e = tid; e < 640; e += 512) { const int j = e >> 7, c = e & 127; cw[e] = j < 4 ? p.conv_w[j * 1024 + c0 + c] : p.conv_b[c0 + c]; }
    __syncthreads();
    const int fr = lane & 15, fq = lane >> 4;
    const int ch = c0 + 16 * w + fr;
    const float ba = p.b_a[dir * 1024 + ch], bx = p.b_x[dir * 1024 + ch];
    const float ls8 = 8.f * logsigf_(p.lam[dir * 1024 + ch]);
    bf16x8 WA[4], WX[4];
#pragma unroll
    for (int ks = 0; ks < 4; ++ks) { WA[ks] = *(const bf16x8*)(Ba + (16 * w + fr) * 136 + ks * 32 + fq * 8); WX[ks] = *(const bf16x8*)(Bx + (16 * w + fr) * 136 + ks * 32 + fq * 8); }
    __syncthreads();
    bf16_t* hst = Ba; bf16_t* pst = Bx;
    const int i = tid >> 3, cgp = tid & 7;
    u32x4 rx[4][2];
#define LRU_LOAD(idx) do { const int b_ = (idx) / 68, ci_ = (idx) % 68; const bool isl_ = ci_ >= 4; const int cc_ = isl_ ? ci_ - 4 : ci_; const int n_ = isl_ ? SEQ : CTX; const int pos_ = cc_ * 64 + i; \
        const int tok_ = dir ? n_ - 1 - pos_ : pos_; const size_t rb_ = isl_ ? (size_t)b_ * SEQ : (size_t)MLAT + b_ * CTX; \
        _Pragma("unroll") for (int j = 0; j < 4; ++j) { const int tt_ = tok_ + j - 2; \
            if (tt_ >= 0 && tt_ < n_) { const bf16_t* pr = P + (rb_ + tt_) * NIN + C_XR + c0 + cgp * 16; rx[j][0] = *(const u32x4*)pr; rx[j][1] = *(const u32x4*)(pr + 8); } \
            else { rx[j][0] = (u32x4){0u, 0u, 0u, 0u}; rx[j][1] = (u32x4){0u, 0u, 0u, 0u}; } } } while (0)
    if (sub < 272) LRU_LOAD(sub);
    for (int idx = sub; idx < 272; idx += nsub) {
        const int b = idx / 68, ci = idx % 68;
        const bool isl = ci >= 4; const int cc = isl ? ci - 4 : ci; const int n = isl ? SEQ : CTX; const size_t rb = isl ? (size_t)b * SEQ : (size_t)MLAT + b * CTX;
        {
            float xc[16];
#pragma unroll
            for (int j = 0; j < 16; ++j) xc[j] = cw[4 * 128 + cgp * 16 + j];
#pragma unroll
            for (int t4 = 0; t4 < 4; ++t4) { float xv[16]; unpack8(rx[t4][0], xv); unpack8(rx[t4][1], xv + 8);
#pragma unroll
                for (int j = 0; j < 16; ++j) xc[j] += xv[j] * cw[t4 * 128 + cgp * 16 + j]; }
#pragma unroll
            for (int j4 = 0; j4 < 4; ++j4) *(f32x4*)(xc32 + i * 132 + cgp * 16 + 4 * j4) = (f32x4){xc[4 * j4], xc[4 * j4 + 1], xc[4 * j4 + 2], xc[4 * j4 + 3]};
            *(u32x4*)(xcb + i * 136 + cgp * 16) = (u32x4){pk2(xc[0], xc[1]), pk2(xc[2], xc[3]), pk2(xc[4], xc[5]), pk2(xc[6], xc[7])};
            *(u32x4*)(xcb + i * 136 + cgp * 16 + 8) = (u32x4){pk2(xc[8], xc[9]), pk2(xc[10], xc[11]), pk2(xc[12], xc[13]), pk2(xc[14], xc[15])};
            if (idx + nsub < 272) LRU_LOAD(idx + nsub);
        }
        __syncthreads();
        float hcar = 0.f, pcar = 1.f;
#pragma unroll
        for (int tt = 0; tt < 4; ++tt) {
            f32x4 ar = (f32x4){0.f, 0.f, 0.f, 0.f}, ai = (f32x4){0.f, 0.f, 0.f, 0.f};
#pragma unroll
            for (int ks = 0; ks < 4; ++ks) { const bf16x8 A = *(const bf16x8*)(xcb + (tt * 16 + fr) * 136 + ks * 32 + fq * 8);
                ar = __builtin_amdgcn_mfma_f32_16x16x32_bf16(A, WA[ks], ar, 0, 0, 0); ai = __builtin_amdgcn_mfma_f32_16x16x32_bf16(A, WX[ks], ai, 0, 0, 0); }
            float Pj[4], Hj[4];
            float Pl = 1.f, Hl = 0.f;
#pragma unroll
            for (int j = 0; j < 4; ++j) { const int ii = tt * 16 + fq * 4 + j;
                const float r = sigmoidf_(ar[j] + ba), ig = sigmoidf_(ai[j] + bx);
                const float la = r * ls8; const float a = __expf(la);
                const float xcv = xc32[ii * 132 + 16 * w + fr];
                const float u = sqrtf(fmaxf(-expm1_neg(2.f * la), 0.f)) * (ig * xcv);
                Pl = a * Pl; Hl = a * Hl + u; Pj[j] = Pl; Hj[j] = Hl; }
            float Pi = Pl, Hi = Hl;
            { const float Pp = __shfl_up(Pi, 16), Hp = __shfl_up(Hi, 16); if (fq >= 1) { Hi = Pi * Hp + Hi; Pi = Pp * Pi; } }
            { const float Pp = __shfl_up(Pi, 32), Hp = __shfl_up(Hi, 32); if (fq >= 2) { Hi = Pi * Hp + Hi; Pi = Pp * Pi; } }
            float Pe = __shfl_up(Pi, 16), He = __shfl_up(Hi, 16); if (fq == 0) { Pe = 1.f; He = 0.f; }
            const float sin_ = Pe * hcar + He, pin_ = Pe * pcar;
            const float Pt = __shfl(Pi, 48 + fr), Ht = __shfl(Hi, 48 + fr);
#pragma unroll
            for (int j = 0; j < 4; ++j) { const int ii = tt * 16 + fq * 4 + j; const int pos = cc * 64 + ii; const int tok = dir ? n - 1 - pos : pos;
                hst[ii * 136 + 16 * w + fr] = (bf16_t)f2bf(Pj[j] * sin_ + Hj[j]);
                pst[ii * 136 + 16 * w + fr] = (bf16_t)f2bf(Pj[j] * pin_); }
            hcar = Pt * hcar + Ht; pcar = Pt * pcar;
        }
        if (fq == 0) { const size_t to = ((size_t)(b * 2 + dir) * 68 + ci) * 1024 + ch; totP[to] = pcar; totH[to] = hcar; }
        __syncthreads();
        { const int pos = cc * 64 + i; const int tok = dir ? n - 1 - pos : pos; const size_t go = (rb + tok) * 1024 + c0 + cgp * 16;
          const u32x4 h0 = *(const u32x4*)(hst + i * 136 + cgp * 16), h1 = *(const u32x4*)(hst + i * 136 + cgp * 16 + 8);
          const u32x4 p0 = *(const u32x4*)(pst + i * 136 + cgp * 16), p1 = *(const u32x4*)(pst + i * 136 + cgp * 16 + 8);
          *(u32x4*)(hbuf + go) = h0; *(u32x4*)(hbuf + go + 8) = h1; *(u32x4*)(pcbuf + go) = p0; *(u32x4*)(pcbuf + go + 8) = p1; }
    }
#undef LRU_LOAD
}
__device__ __forceinline__ void lru_apply(const Params& p, int role) {
    const int tid = threadIdx.x;
    const int cg64 = role & 15, dir = (role >> 4) & 1, b = role >> 5;
    const int i = tid >> 3, c8 = tid & 7; const int ch = cg64 * 64 + c8 * 8;
    bf16_t* hbuf = (bf16_t*)(p.ws + (dir ? WS_HB : WS_HF));
    const bf16_t* pcbuf = (const bf16_t*)((const unsigned char*)p.out + (dir ? DO_PC1 : DO_PC0));
    const float* totP = (const float*)((const unsigned char*)p.out + DO_TOT) + (size_t)(b * 2 + dir) * 68 * 1024 + ch; const float* totH = totP + (size_t)8 * 68 * 1024;
    float cin[8];
#pragma unroll
    for (int j = 0; j < 8; ++j) cin[j] = 0.f;
    for (int c4 = 0; c4 < 68; c4 += 4) {
        u32x4 pw[4], hw[4]; f32x4 tp[4][2], th[4][2]; size_t off[4];
#pragma unroll
        for (int q = 0; q < 4; ++q) { const int ci = c4 + q;
            const bool isl = ci >= 4; const int cc = isl ? ci - 4 : ci; const int n = isl ? SEQ : CTX; const size_t rb = isl ? (size_t)b * SEQ : (size_t)MLAT + b * CTX;
            const int pos = cc * 64 + i; const int tok = dir ? n - 1 - pos : pos;
            off[q] = (rb + tok) * 1024 + ch;
            pw[q] = *(const u32x4*)(pcbuf + off[q]); hw[q] = *(const u32x4*)(hbuf + off[q]);
            tp[q][0] = *(const f32x4*)(totP + (size_t)ci * 1024); tp[q][1] = *(const f32x4*)(totP + (size_t)ci * 1024 + 4);
            th[q][0] = *(const f32x4*)(totH + (size_t)ci * 1024); th[q][1] = *(const f32x4*)(totH + (size_t)ci * 1024 + 4); }
#pragma unroll
        for (int q = 0; q < 4; ++q) {
            float pc[8], hl[8]; unpack8(pw[q], pc); unpack8(hw[q], hl);
            float hv[8];
#pragma unroll
            for (int j = 0; j < 8; ++j) hv[j] = pc[j] * cin[j] + hl[j];
            *(u32x4*)(hbuf + off[q]) = (u32x4){pk2(hv[0], hv[1]), pk2(hv[2], hv[3]), pk2(hv[4], hv[5]), pk2(hv[6], hv[7])};
            const float tpv[8] = {tp[q][0].x, tp[q][0].y, tp[q][0].z, tp[q][0].w, tp[q][1].x, tp[q][1].y, tp[q][1].z, tp[q][1].w};
            const float thv[8] = {th[q][0].x, th[q][0].y, th[q][0].z, th[q][0].w, th[q][1].x, th[q][1].y, th[q][1].z, th[q][1].w};
#pragma unroll
            for (int j = 0; j < 8; ++j) cin[j] = tpv[j] * cin[j] + thv[j];
        }
    }
}

__device__ __forceinline__ void phase_merge(const Params& p) {
    const int lane = threadIdx.x & 63, gw = blockIdx.x * 8 + (threadIdx.x >> 6), NGW = gridDim.x * 8;
    const bf16_t* P = (const bf16_t*)(p.ws + WS_P); const bf16_t* of = (const bf16_t*)(p.ws + WS_OF); const bf16_t* ob = (const bf16_t*)(p.ws + WS_OB);
    const bf16_t* hf = (const bf16_t*)(p.ws + WS_HF); const bf16_t* hb = (const bf16_t*)(p.ws + WS_HB); bf16_t* A = (bf16_t*)(p.ws + WS_A);
    for (int m = gw; m < MALL; m += NGW) {
        const bf16_t* pr = P + (size_t)m * NIN;
        u32x2 wf[4], wb[4], og[4], ha[4], hbv[4], yv[4];
#pragma unroll
        for (int h = 0; h < 4; ++h) { const int c = h * 256 + 4 * lane;
            wf[h] = *(const u32x2*)(of + (size_t)m * 1024 + c); wb[h] = *(const u32x2*)(ob + (size_t)m * 1024 + c); og[h] = *(const u32x2*)(pr + C_OG + c);
            ha[h] = *(const u32x2*)(hf + (size_t)m * 1024 + c); hbv[h] = *(const u32x2*)(hb + (size_t)m * 1024 + c); yv[h] = *(const u32x2*)(pr + C_YR + c); }
#pragma unroll
        for (int h = 0; h < 4; ++h) { const int c = h * 256 + 4 * lane;
            const f32x4 o = (f32x4){bflo(wf[h].x) + bflo(wb[h].x), bfhi(wf[h].x) + bfhi(wb[h].x), bflo(wf[h].y) + bflo(wb[h].y), bfhi(wf[h].y) + bfhi(wb[h].y)};
            const float ss = wave_sum((o.x * o.x + o.y * o.y) + (o.z * o.z + o.w * o.w));
            const float rstd = rsqrtf(ss * (1.f / 256.f) + EPS);
            const f32x4 gg = *(const f32x4*)(p.gla_g + c);
            const float r0 = o.x * rstd * gg.x * siluf_(bflo(og[h].x)), r1 = o.y * rstd * gg.y * siluf_(bfhi(og[h].x));
            const float r2 = o.z * rstd * gg.z * siluf_(bflo(og[h].y)), r3 = o.w * rstd * gg.w * siluf_(bfhi(og[h].y));
            *(u32x2*)(A + (size_t)m * D + c) = (u32x2){pk2(r0, r1), pk2(r2, r3)}; }
#pragma unroll
        for (int j = 0; j < 4; ++j) { const int c = 256 * j + 4 * lane;
            const u32x2 a = ha[j], bb = hbv[j], y = yv[j];
            const float r0 = (bflo(a.x) + bflo(bb.x)) * gelu_tanh(bflo(y.x)), r1 = (bfhi(a.x) + bfhi(bb.x)) * gelu_tanh(bfhi(y.x));
            const float r2 = (bflo(a.y) + bflo(bb.y)) * gelu_tanh(bflo(y.y)), r3 = (bfhi(a.y) + bfhi(bb.y)) * gelu_tanh(bfhi(y.y));
            *(u32x2*)(A + (size_t)m * D + 1024 + c) = (u32x2){pk2(r0, r1), pk2(r2, r3)}; }
    }
}

constexpr int NA_KT = 0, NA_VT = 34816, NA_PW = 71680, NA_RB = 108544, NA_END = 110592;
static_assert(NA_END <= LDS_BYTES, "na lds");
__device__ __forceinline__ void phase_na(const Params& p, unsigned char* lds) {
    const int tid = threadIdx.x, lane = tid & 63, w = __builtin_amdgcn_readfirstlane(tid >> 6), fr = lane & 15, fq = lane >> 4;
    bf16_t* KtB = (bf16_t*)(lds + NA_KT); bf16_t* vtB = (bf16_t*)(lds + NA_VT); bf16_t* Pw = (bf16_t*)(lds + NA_PW) + w * (32 * 72); float* rbt = (float*)(lds + NA_RB);
    const bf16_t* QK = (const bf16_t*)(p.ws + WS_P); const bf16_t* VTg = (const bf16_t*)(p.ws + WS_VT); bf16_t* O = (bf16_t*)(p.ws + WS_A);
    const int key = tid >> 3, part = tid & 7;
    const int vd = tid >> 2, vc4 = tid & 3;
    const float scale = 0.08838834764831845f * 1.4426950408889634f;
    for (int u = blockIdx.x; u < 1024; u += gridDim.x) {
        const int r4 = u & 15, h = (u >> 4) & 15, b = u >> 8, r0 = 4 * r4;
        const int rs_lo = min(max(r0 - 4, 0), 56), rs_hi = min(max(r0 - 1, 0), 56);
        const int ntile = 4 + (rs_hi + 8 - rs_lo);
        const int qr = r0 + (w >> 1), qc0 = 32 * (w & 1);
        const int rsq = min(max(qr - 4, 0), 56);
        __syncthreads();
        for (int e = tid; e < 465; e += 512) rbt[e] = p.rel_bias[h * 465 + e] * 1.4426950408889634f;
        bf16x8 aq[2][4];
#pragma unroll
        for (int mt = 0; mt < 2; ++mt) { const bf16_t* qp = QK + (size_t)(b * SEQ + qr * 64 + qc0 + 16 * mt + fr) * NQK + h * 128 + fq * 8;
#pragma unroll
            for (int ks = 0; ks < 4; ++ks) aq[mt][ks] = *(const bf16x8*)(qp + ks * 32); }
        f32x4 Oa[2][8];
#pragma unroll
        for (int mt = 0; mt < 2; ++mt)
#pragma unroll
            for (int dt = 0; dt < 8; ++dt) Oa[mt][dt] = (f32x4){0.f, 0.f, 0.f, 0.f};
        float mrow[2] = {-1e30f, -1e30f}, lrow[2] = {0.f, 0.f};
        u32x4 ra[4];
#define NA_LOAD(R, kt) do { const size_t row0_ = (kt) < 4 ? (size_t)MLAT + b * CTX + (kt) * 64 : (size_t)b * SEQ + (rs_lo + (kt) - 4) * 64; \
        const bf16_t* pk = QK + (row0_ + key) * NQK + D + h * 128 + part * 16; const bf16_t* pv = VTg + (size_t)(h * 128 + vd) * MALL + row0_ + vc4 * 16; \
        R[0] = *(const u32x4*)pk; R[1] = *(const u32x4*)(pk + 8); R[2] = *(const u32x4*)pv; R[3] = *(const u32x4*)(pv + 8); } while (0)
#define NA_WRITE(R, buf) do { bf16_t* kd = KtB + (buf) * (64 * 136) + key * 136 + part * 16; bf16_t* vdp = vtB + (buf) * (128 * 72) + vd * 72 + vc4 * 16; \
        *(u32x4*)kd = R[0]; *(u32x4*)(kd + 8) = R[1]; *(u32x4*)vdp = R[2]; *(u32x4*)(vdp + 8) = R[3]; } while (0)
        NA_LOAD(ra, 0); NA_WRITE(ra, 0);
        NA_LOAD(ra, 1);
        __syncthreads();
        for (int kt = 0; kt < ntile; ++kt) {
            if (kt + 1 < ntile) { NA_WRITE(ra, (kt + 1) & 1); if (kt + 2 < ntile) NA_LOAD(ra, kt + 2); }
            const bool band = kt >= 4; const int kr = rs_lo + kt - 4;
            if (!(band && (kr < rsq || kr >= rsq + 8))) {
                const bf16_t* Kt = KtB + (kt & 1) * (64 * 136); const bf16_t* vt = vtB + (kt & 1) * (128 * 72);
                f32x4 st[2][4];
                const int wlo0 = min(max(qc0 - 8, 0), 48), whi0 = min(max(qc0 + 7, 0), 48) + 16, wlo1 = min(max(qc0 + 8, 0), 48), whi1 = min(max(qc0 + 23, 0), 48) + 16;
#pragma unroll
                for (int nt = 0; nt < 4; ++nt) {
                    const bool act0 = !band || (16 * nt < whi0 && 16 * nt + 16 > wlo0), act1 = !band || (16 * nt < whi1 && 16 * nt + 16 > wlo1);
                    st[0][nt] = (f32x4){0.f, 0.f, 0.f, 0.f}; st[1][nt] = (f32x4){0.f, 0.f, 0.f, 0.f};
                    if (act0 || act1) {
                        bf16x8 Bk[4];
#pragma unroll
                        for (int ks = 0; ks < 4; ++ks) Bk[ks] = *(const bf16x8*)(Kt + (nt * 16 + fr) * 136 + ks * 32 + fq * 8);
#pragma unroll
                        for (int ks = 0; ks < 4; ++ks) {
                            if (act0) st[0][nt] = __builtin_amdgcn_mfma_f32_16x16x32_bf16(Bk[ks], aq[0][ks], st[0][nt], 0, 0, 0);
                            if (act1) st[1][nt] = __builtin_amdgcn_mfma_f32_16x16x32_bf16(Bk[ks], aq[1][ks], st[1][nt], 0, 0, 0); }
                    }
                }
                unsigned pk[2][4][2];
#pragma unroll
                for (int mt = 0; mt < 2; ++mt) {
                    __builtin_amdgcn_sched_barrier(0);
                    const int c = qc0 + 16 * mt + fr; const int cs = min(max(c - 8, 0), 48); const int wlo = mt ? wlo1 : wlo0, whi = mt ? whi1 : whi0;
                    float mx = -1e30f;
#pragma unroll
                    for (int nt = 0; nt < 4; ++nt) {
                        const bool act = !band || (16 * nt < whi && 16 * nt + 16 > wlo);
                        if (act) {
#pragma unroll
                            for (int j = 0; j < 4; ++j) { float v = st[mt][nt][j] * scale;
                                if (band) { const int kc = nt * 16 + fq * 4 + j; const bool valid = kc >= cs && kc < cs + 16; const int dci = min(max(kc - c + 15, 0), 30);
                                    v += rbt[(kr - qr + 7) * 31 + dci]; v = valid ? v : -1e30f; }
                                st[mt][nt][j] = v; mx = fmaxf(mx, v); }
                        }
                    }
                    mx = fmaxf(mx, __shfl_xor(mx, 16)); mx = fmaxf(mx, __shfl_xor(mx, 32));
                    const bool resc = !__all(mx - mrow[mt] <= 8.0f);
                    float mn = mrow[mt], alpha = 1.f;
                    if (resc) { mn = fmaxf(mrow[mt], mx); alpha = __builtin_amdgcn_exp2f(mrow[mt] - mn); mrow[mt] = mn; }
                    float ls = 0.f;
#pragma unroll
                    for (int nt = 0; nt < 4; ++nt) {
                        const bool act = !band || (16 * nt < whi && 16 * nt + 16 > wlo);
                        if (act) { const float p0 = __builtin_amdgcn_exp2f(st[mt][nt][0] - mn), p1 = __builtin_amdgcn_exp2f(st[mt][nt][1] - mn), p2 = __builtin_amdgcn_exp2f(st[mt][nt][2] - mn), p3 = __builtin_amdgcn_exp2f(st[mt][nt][3] - mn);
                            ls += (p0 + p1) + (p2 + p3); pk[mt][nt][0] = pk2(p0, p1); pk[mt][nt][1] = pk2(p2, p3); }
                        else { pk[mt][nt][0] = 0u; pk[mt][nt][1] = 0u; }
                    }
                    lrow[mt] = lrow[mt] * alpha + ls;
                    if (resc) {
#pragma unroll
                        for (int dt = 0; dt < 8; ++dt) Oa[mt][dt] = Oa[mt][dt] * alpha; }
                }
                __builtin_amdgcn_sched_barrier(0);
#pragma unroll
                for (int kk = 0; kk < 2; ++kk) {
                    const int ta = 2 * kk, tb = 2 * kk + 1;
                    const bf16x8 Bp0 = as_bf16x8((u32x4){pk[0][ta][0], pk[0][ta][1], pk[0][tb][0], pk[0][tb][1]}), Bp1 = as_bf16x8((u32x4){pk[1][ta][0], pk[1][ta][1], pk[1][tb][0], pk[1][tb][1]});
#pragma unroll
                    for (int dt = 0; dt < 8; ++dt) {
                        const u32x2 va = *(const u32x2*)(vt + (dt * 16 + fr) * 72 + 16 * ta + fq * 4), vb = *(const u32x2*)(vt + (dt * 16 + fr) * 72 + 16 * tb + fq * 4);
                        const bf16x8 Av = as_bf16x8((u32x4){va.x, va.y, vb.x, vb.y});
                        Oa[0][dt] = __builtin_amdgcn_mfma_f32_16x16x32_bf16(Av, Bp0, Oa[0][dt], 0, 0, 0);
                        Oa[1][dt] = __builtin_amdgcn_mfma_f32_16x16x32_bf16(Av, Bp1, Oa[1][dt], 0, 0, 0); }
                    __builtin_amdgcn_sched_group_barrier(0x100, 8, 0);
#pragma unroll
                    for (int q = 0; q < 4; ++q) { __builtin_amdgcn_sched_group_barrier(0x008, 2, 0); __builtin_amdgcn_sched_group_barrier(0x100, 2, 0); }
                    __builtin_amdgcn_sched_group_barrier(0x008, 8, 0);
                    __builtin_amdgcn_sched_barrier(0);
                }
            }
            __syncthreads();
        }
        { bf16_t* ost = KtB + w * (32 * 136);
#pragma unroll
          for (int mt = 0; mt < 2; ++mt) {
            float l = lrow[mt]; l += __shfl_xor(l, 16); l += __shfl_xor(l, 32); const float inv = 1.f / l;
#pragma unroll
            for (int dt = 0; dt < 8; ++dt) *(u32x2*)(ost + (mt * 16 + fr) * 136 + dt * 16 + fq * 4) = (u32x2){pk2(Oa[mt][dt][0] * inv, Oa[mt][dt][1] * inv), pk2(Oa[mt][dt][2] * inv, Oa[mt][dt][3] * inv)}; }
          asm volatile("s_waitcnt lgkmcnt(0)" ::: "memory");
          const int q = lane >> 1, hf = lane & 1;
          bf16_t* op = O + (size_t)(b * SEQ + qr * 64 + qc0 + q) * D + h * 128 + hf * 64;
#pragma unroll
          for (int e = 0; e < 8; ++e) *(u32x4*)(op + e * 8) = *(const u32x4*)(ost + q * 136 + hf * 64 + e * 8); }
#undef NA_LOAD
#undef NA_WRITE
    }
    __syncthreads();
}

__device__ __forceinline__ void phase_final(const Params& p) {
    const int lane = threadIdx.x & 63, gw = blockIdx.x * 8 + (threadIdx.x >> 6), NGW = gridDim.x * 8;
    f32x4 gg[8];
#pragma unroll
    for (int j = 0; j < 8; ++j) gg[j] = *(const f32x4*)(p.fin_g + 256 * j + 4 * lane);
    int m = gw;
    for (; m + NGW < MLAT; m += 2 * NGW) {
        float* x0 = p.out + (size_t)m * D; float* x1 = p.out + (size_t)(m + NGW) * D;
        f32x4 v0[8], v1[8]; float s0 = 0.f, s1 = 0.f;
#pragma unroll
        for (int j = 0; j < 8; ++j) { v0[j] = *(const f32x4*)(x0 + 256 * j + 4 * lane); v1[j] = *(const f32x4*)(x1 + 256 * j + 4 * lane); }
#pragma unroll
        for (int j = 0; j < 8; ++j) { s0 += (v0[j].x * v0[j].x + v0[j].y * v0[j].y) + (v0[j].z * v0[j].z + v0[j].w * v0[j].w); s1 += (v1[j].x * v1[j].x + v1[j].y * v1[j].y) + (v1[j].z * v1[j].z + v1[j].w * v1[j].w); }
        const float r0 = rsqrtf(wave_sum(s0) * (1.f / D) + EPS), r1 = rsqrtf(wave_sum(s1) * (1.f / D) + EPS);
#pragma unroll
        for (int j = 0; j < 8; ++j) { *(f32x4*)(x0 + 256 * j + 4 * lane) = v0[j] * r0 * gg[j]; *(f32x4*)(x1 + 256 * j + 4 * lane) = v1[j] * r1 * gg[j]; }
    }
    for (; m < MLAT; m += NGW) {
        float* xr = p.out + (size_t)m * D;
        f32x4 v[8]; float ss = 0.f;
#pragma unroll
        for (int j = 0; j < 8; ++j) { v[j] = *(const f32x4*)(xr + 256 * j + 4 * lane); ss += (v[j].x * v[j].x + v[j].y * v[j].y) + (v[j].z * v[j].z + v[j].w * v[j].w); }
        const float rstd = rsqrtf(wave_sum(ss) * (1.f / D) + EPS);
#pragma unroll
        for (int j = 0; j < 8; ++j) *(f32x4*)(xr + 256 * j + 4 * lane) = v[j] * rstd * gg[j];
    }
}

#define XB_TMO      128
#define XB_XCNT(j)  (256  + 64 * (j))
#define XB_XSUB(j)  (1280 + 64 * (j))
#define XB_XGEN(j)  (2304 + 64 * (j))
#define XB_TOP      3328
#define XB_TOPGEN   3392
#define XCD_BAR_WORDS 3456
#define XB_SPIN_CAP (1u << 18)
__device__ __forceinline__ unsigned xb_ld(unsigned* p)              { return __hip_atomic_load(p, __ATOMIC_RELAXED, __HIP_MEMORY_SCOPE_AGENT); }
__device__ __forceinline__ unsigned xb_add(unsigned* p, unsigned v) { return __hip_atomic_fetch_add(p, v, __ATOMIC_RELAXED, __HIP_MEMORY_SCOPE_AGENT); }
__device__ __forceinline__ unsigned xb_xcc_id() { return (unsigned)__builtin_amdgcn_s_getreg((3 << 11) | 20) & 0xFu; }
#define XB_SPIN(cond, bar) do { unsigned _sp = 0; while (cond) { __builtin_amdgcn_s_sleep(1); \
    if ((++_sp & 255u) == 0u) { if (xb_ld(&(bar)[XB_TMO])) break; if (_sp > XB_SPIN_CAP) { atomicAdd(&(bar)[XB_TMO], 1u); break; } } } } while (0)
struct XcdBarrier { unsigned* bar; unsigned x; volatile LAS unsigned* st; };
__device__ __forceinline__ XcdBarrier xcd_barrier_post(unsigned* bar, volatile LAS unsigned* st) {
    XcdBarrier b; b.bar = bar; b.x = xb_xcc_id(); b.st = st;
    if (threadIdx.x == 0) (void)xb_add(&bar[XB_XCNT(b.x)], 1u);
    return b;
}
__device__ __forceinline__ void xcd_barrier_complete(unsigned* bar, unsigned x, unsigned& nloc, unsigned& nx) {
    const unsigned G = gridDim.x * gridDim.y * gridDim.z;
    unsigned sum, cnt, mine, sp = 0u;
    for (;;) {
        sum = 0u; cnt = 0u; mine = 0u;
#pragma unroll
        for (unsigned j = 0; j < 16; ++j) { const unsigned c = xb_ld(&bar[XB_XCNT(j)]); sum += c; cnt += (c > 0u) ? 1u : 0u; mine = (j == x) ? c : mine; }
        if (sum == G) break;
        __builtin_amdgcn_s_sleep(1);
        if ((++sp & 255u) == 0u) { if (xb_ld(&bar[XB_TMO])) break; if (sp > XB_SPIN_CAP) { atomicAdd(&bar[XB_TMO], 1u); break; } }
    }
    nloc = mine > 0u ? mine : 1u; nx = cnt > 0u ? cnt : 1u;
}
__device__ __forceinline__ void xcd_barrier(const XcdBarrier& b) {
    asm volatile("s_waitcnt vmcnt(0)" ::: "memory");
    __syncthreads();
    if (threadIdx.x == 0) {
        unsigned* bar = b.bar;
        __builtin_amdgcn_s_waitcnt(0);
        unsigned nloc = b.st[0], nx = b.st[1];
        if (nloc == 0u) { xcd_barrier_complete(bar, b.x, nloc, nx); b.st[0] = nloc; b.st[1] = nx; }
        const unsigned old = xb_add(&bar[XB_XSUB(b.x)], 1u);
        const unsigned gen = old / nloc;
        if (old + 1u == (gen + 1u) * nloc) {
            __builtin_amdgcn_fence(__ATOMIC_RELEASE, "agent");
            asm volatile("s_waitcnt vmcnt(0)" ::: "memory");
            const unsigned og = xb_add(&bar[XB_TOP], 1u);
            const unsigned tg = og / nx;
            if (og + 1u == (tg + 1u) * nx) xb_add(&bar[XB_TOPGEN], 1u);
            else XB_SPIN(xb_ld(&bar[XB_TOPGEN]) == tg, bar);
            __builtin_amdgcn_fence(__ATOMIC_ACQUIRE, "agent");
            xb_add(&bar[XB_XGEN(b.x)], 1u);
            asm volatile("s_waitcnt vmcnt(0)" ::: "memory");
        } else {
            XB_SPIN(xb_ld(&bar[XB_XGEN(b.x)]) == gen, bar);
            __builtin_amdgcn_fence(__ATOMIC_ACQUIRE, "agent");
            asm volatile("s_waitcnt vmcnt(0)" ::: "memory");
        }
    }
    __syncthreads();
}

constexpr int N_PHASES = 17;
#ifndef ONLYP
#define ONLYP -1
#endif
#define PH(k) (ONLYP < 0 || ONLYP == (k))
#ifndef REPP
#define REPP -1
#endif
#define NREP(k) ((REPP == (k)) ? 2 : 1)
__device__ __forceinline__ void run_gemm_store(const Params& p, LAS unsigned char* ldsl, const int ph) {
    unsigned char* ws = p.ws; const int l1 = ph >= 9; const int Mrows = ph >= 12 ? MLAT : MALL;
    const bf16_t* A = (const bf16_t*)(ws + WS_A);
    pg8::Gemm g{D}; pg8::SegOrder S; S.init(D, gridDim.x, blockIdx.x);
    pg8::EpiBf16 E{(bf16_t*)(ws + WS_P), NIN, (bf16_t*)(ws + WS_VT), MALL, 0};
    if (ph == 2) { S.add(A, ws + WS_WIN, MALL / 256, NIN / 256, 1, D / 64, 0); S.add(ws + WS_WV0, A, 1024 / 256, MALL / 256, 1, D / 64, 1); }
    else if (ph == 10) { E.ldc0 = NQK; S.add(A, ws + WS_WQKV, MALL / 256, NQK / 256, 1, D / 64, 0); S.add((const bf16_t*)(ws + WS_WQKV) + (size_t)NQK * D, A, D / 256, MALL / 256, 1, D / 64, 1); }
    else { E.O0 = (bf16_t*)(ws + WS_H); E.ldc0 = DFF; E.ACT = 1; S.add(A, (const bf16_t*)(ws + WS_WUP) + (size_t)l1 * D * DFF, Mrows / 256, DFF / 256, 1, D / 64, 0); }
    pg8::gemm_phase<pg8::EpiBf16, pg8::SegOrder, true, true>(ldsl, g, S, E);
}
__device__ __forceinline__ void run_gemm_resid(const Params& p, LAS unsigned char* ldsl, const int ph) {
    unsigned char* ws = p.ws; const int l1 = ph >= 9;
    const float* modl = (const float*)(ws + WS_MODV) + (size_t)l1 * 5 * (6 * D);
    float* xcb = (float*)(ws + WS_XC);
    const bool dn = (ph == 8 || ph == 15);
    const int K = dn ? DFF : D;
    const bf16_t* A = dn ? (const bf16_t*)(ws + WS_H) : (const bf16_t*)(ws + WS_A);
    const bf16_t* Bt = dn ? (const bf16_t*)(ws + WS_WDN) + (size_t)l1 * D * DFF : (ph == 5 ? (const bf16_t*)(ws + WS_WOUT) : (const bf16_t*)(ws + WS_WNO));
    pg8::Gemm g{K}; pg8::SegOrder S; S.init(K, gridDim.x, blockIdx.x);
    S.add(A, Bt, MLAT / 256, D / 256, 1, K / 64, 0);
    if (!l1) S.add(A + (size_t)MLAT * K, Bt, MCTX / 256, D / 256, 8, K / 64 / 8, 1);
    pg8::EpiResid E{ph == 5 ? p.x : p.out, p.out, (float*)(ws + WS_PART), modl + (dn ? 5 : 2) * D};
    pg8::gemm_phase<pg8::EpiResid, pg8::SegOrder, true, true>(ldsl, g, S, E);
}
__global__ void __launch_bounds__(512, 2) fwd_megakernel(Params p) {
    extern __shared__ __attribute__((aligned(16))) unsigned char lds[];
    cg::grid_group grid = cg::this_grid();
    LAS unsigned char* ldsl = (LAS unsigned char*)lds;
    const int lo = p.ph_lo, hi = p.ph_hi;
    float* xcb = (float*)(p.ws + WS_XC);
#define IN(k) (lo <= (k) && (k) < hi)
    if (threadIdx.x < 2) ((volatile LAS unsigned*)(ldsl + LDS_BYTES - 64))[threadIdx.x] = 0u;
    __syncthreads();
    const XcdBarrier xb = xcd_barrier_post((unsigned*)(p.ws + WS_BAR), (volatile LAS unsigned*)(ldsl + LDS_BYTES - 64));
    if (p.ph_hi > 1000) grid.sync();
#define GSYNC() xcd_barrier(xb)
#define SEAM(k) do { if (IN(k) && IN((k) + 1)) GSYNC(); } while (0)
    if (IN(0)) { for (int rep_ = 0; rep_ < NREP(0); ++rep_) { if (rep_) GSYNC(); if (PH(0)) phase_mod(p, lds, 0, 0, gridDim.x); } } SEAM(0);
    if (IN(1)) { for (int rep_ = 0; rep_ < NREP(1); ++rep_) { if (rep_) GSYNC(); if (PH(1)) { phase_convert(p, lds, 0, 0, gridDim.x); phase_modulate(p, p.x, p.ctx, p.norm1_g, 0, 0, MALL, -1, 0); } } } SEAM(1);
    if (IN(2)) { for (int rep_ = 0; rep_ < NREP(2); ++rep_) { if (rep_) GSYNC(); if (PH(2)) run_gemm_store(p, ldsl, 2); } } SEAM(2);
    if (IN(3)) { for (int rep_ = 0; rep_ < NREP(3); ++rep_) { if (rep_) GSYNC(); if (PH(3)) { gla_pre(p, lds); lru_pre(p, lds); GSYNC(); for (int role = blockIdx.x; role < 256; role += gridDim.x) { if (role < 128) gla_seq(p, lds, role); else lru_apply(p, role - 128); }
        { const int wb0 = gridDim.x >= 256 ? 128 : 0, nwb = gridDim.x - wb0; if ((int)blockIdx.x >= wb0) { phase_convert(p, lds, 1, wb0, nwb); phase_mod(p, lds, 1, wb0, nwb); } } } } } SEAM(3);
    if (IN(4)) { for (int rep_ = 0; rep_ < NREP(4); ++rep_) { if (rep_) GSYNC(); if (PH(4)) phase_merge(p); } } SEAM(4);
    if (IN(5)) { for (int rep_ = 0; rep_ < NREP(5); ++rep_) { if (rep_) GSYNC(); if (PH(5)) run_gemm_resid(p, ldsl, 5); } } SEAM(5);
    if (IN(6)) { for (int rep_ = 0; rep_ < NREP(6); ++rep_) { if (rep_) GSYNC(); if (PH(6)) phase_modulate(p, p.out, p.ctx, p.norm2_g, 0, 1, MALL, 2, 0); } } SEAM(6);
    if (IN(7)) { for (int rep_ = 0; rep_ < NREP(7); ++rep_) { if (rep_) GSYNC(); if (PH(7)) run_gemm_store(p, ldsl, 7); } } SEAM(7);
    if (IN(8)) { for (int rep_ = 0; rep_ < NREP(8); ++rep_) { if (rep_) GSYNC(); if (PH(8)) run_gemm_resid(p, ldsl, 8); } } SEAM(8);
    if (IN(9)) { for (int rep_ = 0; rep_ < NREP(9); ++rep_) { if (rep_) GSYNC(); if (PH(9)) phase_modulate(p, p.out, xcb, p.norm1_g + D, 1, 0, MALL, 5, 0); } } SEAM(9);
    if (IN(10)) { for (int rep_ = 0; rep_ < NREP(10); ++rep_) { if (rep_) GSYNC(); if (PH(10)) run_gemm_store(p, ldsl, 10); } } SEAM(10);
    if (IN(11)) { for (int rep_ = 0; rep_ < NREP(11); ++rep_) { if (rep_) GSYNC(); if (PH(11)) phase_na(p, lds); } } SEAM(11);
    if (IN(12)) { for (int rep_ = 0; rep_ < NREP(12); ++rep_) { if (rep_) GSYNC(); if (PH(12)) run_gemm_resid(p, ldsl, 12); } } SEAM(12);
    if (IN(13)) { for (int rep_ = 0; rep_ < NREP(13); ++rep_) { if (rep_) GSYNC(); if (PH(13)) phase_modulate(p, p.out, xcb, p.norm2_g + D, 1, 1, MLAT, -1, 0); } } SEAM(13);
    if (IN(14)) { for (int rep_ = 0; rep_ < NREP(14); ++rep_) { if (rep_) GSYNC(); if (PH(14)) run_gemm_store(p, ldsl, 14); } } SEAM(14);
    if (IN(15)) { for (int rep_ = 0; rep_ < NREP(15); ++rep_) { if (rep_) GSYNC(); if (PH(15)) run_gemm_resid(p, ldsl, 15); } } SEAM(15);
    if (IN(16)) { for (int rep_ = 0; rep_ < NREP(16); ++rep_) { if (rep_) GSYNC(); if (PH(16)) phase_final(p); } }
#undef IN
#undef SEAM
}

extern "C" void kernel_launch(void* const* d_in, const int* in_sizes, int n_in, void* d_out, int out_size, void* d_ws, size_t ws_size, hipStream_t stream) {
    static int grid = 0;
    if (grid == 0) {
        if (n_in != 26 || out_size != MLAT * D || ws_size < WS_END) { fprintf(stderr, "kernel_launch: unexpected shapes (n_in %d out %d ws %zu)\n", n_in, out_size, ws_size); grid = -1; return; }
        int dev = 0, cus = 0, per_cu = 0;
        hipGetDevice(&dev); hipDeviceGetAttribute(&cus, hipDeviceAttributeMultiprocessorCount, dev);
        hipFuncSetAttribute((const void*)fwd_megakernel, hipFuncAttributeMaxDynamicSharedMemorySize, LDS_BYTES);
        hipOccupancyMaxActiveBlocksPerMultiprocessor(&per_cu, (const void*)fwd_megakernel, 512, LDS_BYTES);
        if (per_cu < 1) { fprintf(stderr, "kernel_launch: occupancy query returned %d\n", per_cu); per_cu = 1; }
        grid = cus * 1;
        (void)hipGetLastError();
    }
    if (grid < 0) return;
    if (hipMemsetAsync((char*)d_ws + WS_BAR, 0, 16384, stream) != hipSuccess) { fprintf(stderr, "kernel_launch: memset of the barrier words failed\n"); return; }
    Params p{};
    const float** f = (const float**)&p;
    for (int i = 0; i < 26; ++i) f[i] = (const float*)d_in[i];
    p.out = (float*)d_out; p.ws = (unsigned char*)d_ws; p.ph_lo = 0; p.ph_hi = N_PHASES;
    void* args[] = {&p};
    hipError_t e = hipLaunchCooperativeKernel((const void*)fwd_megakernel, dim3(grid), dim3(512), args, LDS_BYTES, stream);
    if (e != hipSuccess) fprintf(stderr, "cooperative launch failed: %s (grid %d)\n", hipGetErrorString(e), grid);
}
```

```cpp
#include <hip/hip_runtime.h>
#include <hip/hip_cooperative_groups.h>
#include <cstdio>
#include <cstdint>
namespace cg = cooperative_groups;

#define LAS __attribute__((address_space(3)))
typedef unsigned short bf16_t;
typedef short bf16x8 __attribute__((ext_vector_type(8)));
typedef float f32x4 __attribute__((ext_vector_type(4)));
typedef float f32x2 __attribute__((ext_vector_type(2)));
typedef unsigned u32x4 __attribute__((ext_vector_type(4)));
typedef unsigned u32x2 __attribute__((ext_vector_type(2)));

constexpr int D = 2048, NB = 4, SEQ = 4096, CTX = 256, DFF = 8192;
constexpr int MLAT = NB * SEQ, MCTX = NB * CTX, MALL = MLAT + MCTX;
constexpr int NIN = 4352;
constexpr int C_Q = 0, C_K = 512, C_OG = 1024, C_XR = 2048, C_YR = 3072, C_GL = 4096;
constexpr int NQKV = 6144, NQK = 4096;
constexpr float EPS = 1e-6f;

constexpr size_t MiB = 1u << 20;
constexpr size_t WS_MODV = 0;
constexpr size_t WS_BAR = 544 * 1024;
constexpr size_t WS_ROPE = 512 * 1024;
constexpr size_t WS_WIN = 1 * MiB;
constexpr size_t WS_WV0 = 18 * MiB;
constexpr size_t WS_WOUT = 22 * MiB;
constexpr size_t WS_WUP = 30 * MiB;
constexpr size_t WS_WDN = 94 * MiB;
constexpr size_t WS_WQKV = 158 * MiB;
constexpr size_t WS_WNO = 182 * MiB;
constexpr size_t WS_XC = 190 * MiB;
constexpr size_t WS_A = 198 * MiB;
constexpr size_t WS_R = 266 * MiB;
constexpr size_t WS_P = WS_R;
constexpr size_t WS_VT = WS_R + 146 * MiB;
constexpr size_t WS_OF = WS_R + 214 * MiB;
constexpr size_t WS_OB = WS_R + 282 * MiB;
constexpr size_t WS_HF = WS_R + 350 * MiB;
constexpr size_t WS_HB = WS_R + 384 * MiB;
constexpr size_t WS_GQ = WS_A, WS_GK = WS_A + 34 * MiB;
constexpr size_t WS_GATT = WS_R + 418 * MiB, WS_GBLE = WS_R + 435 * MiB;
constexpr size_t WS_PART = WS_R + 300 * MiB;
constexpr size_t WS_H = WS_R;
constexpr size_t WS_LRUW = WS_R + 437 * MiB;
constexpr size_t WS_END = WS_R + 439 * MiB;

constexpr int LDS_BYTES = 147456;

struct Params {
    const float *x, *c, *ctx, *c_ctx, *mod_w, *mod_b, *norm1_g, *norm2_g, *mlp_up, *mlp_down, *ev_w_in, *ev_w_out;
    const float *gate_up, *gate_b, *gla_g, *conv_w, *conv_b, *w_a, *b_a, *w_x, *b_x, *lam, *na_qkv, *na_out, *rel_bias, *fin_g;
    float* out; unsigned char* ws;
    int ph_lo, ph_hi;
};

typedef __bf16 hwbf16x2 __attribute__((ext_vector_type(2)));
__device__ __forceinline__ unsigned f2bf(float f) { return (unsigned)__builtin_bit_cast(unsigned short, (__bf16)f); }
__device__ __forceinline__ unsigned pk2(float lo, float hi) { return __builtin_bit_cast(unsigned, __builtin_convertvector((f32x2){lo, hi}, hwbf16x2)); }
__device__ __forceinline__ float bflo(unsigned w) { return __builtin_bit_cast(float, w << 16); }
__device__ __forceinline__ float bfhi(unsigned w) { return __builtin_bit_cast(float, w & 0xffff0000u); }
__device__ __forceinline__ float bf1(bf16_t v) { return __builtin_bit_cast(float, (unsigned)v << 16); }
__device__ __forceinline__ float wave_sum(float v) {
#pragma unroll
    for (int o = 1; o < 64; o <<= 1) v += __shfl_xor(v, o);
    return v;
}
__device__ __forceinline__ float dpp_ror(float v, const int ctrl) { return v; }
#define ROW_ROR(v, n) __builtin_bit_cast(float, __builtin_amdgcn_update_dpp(0, __builtin_bit_cast(int, (v)), 0x120 + (n), 0xf, 0xf, false))
__device__ __forceinline__ float row16_max(float v) { v = fmaxf(v, ROW_ROR(v, 8)); v = fmaxf(v, ROW_ROR(v, 4)); v = fmaxf(v, ROW_ROR(v, 2)); v = fmaxf(v, ROW_ROR(v, 1)); return v; }
__device__ __forceinline__ float row16_sum(float v) { v += ROW_ROR(v, 8); v += ROW_ROR(v, 4); v += ROW_ROR(v, 2); v += ROW_ROR(v, 1); return v; }
__device__ __forceinline__ float sigmoidf_(float x) { return 1.f / (1.f + __expf(-x)); }
__device__ __forceinline__ float logsigf_(float z) { return fminf(z, 0.f) - __logf(1.f + __expf(-fabsf(z))); }
__device__ __forceinline__ float siluf_(float x) { return x / (1.f + __expf(-x)); }
__device__ __forceinline__ float gelu_tanh(float x) {
    const float u = 0.7978845608028654f * (x + 0.044715f * x * x * x);
    const float t = 1.f - 2.f / (1.f + __expf(2.f * u));
    return 0.5f * x * (1.f + t);
}
__device__ __forceinline__ void unpack8(u32x4 w, float* f) {
    f[0] = bflo(w.x); f[1] = bfhi(w.x); f[2] = bflo(w.y); f[3] = bfhi(w.y); f[4] = bflo(w.z); f[5] = bfhi(w.z); f[6] = bflo(w.w); f[7] = bfhi(w.w);
}
__device__ __forceinline__ bf16x8 as_bf16x8(u32x4 w) { return __builtin_bit_cast(bf16x8, w); }

namespace pg8 {
constexpr int BM = 256, BK = 64, HALF = 128, HTB = HALF * BK * 2, STAGE_BYTES = 8 * HTB, NXCD = 8, WGM = 4;
__host__ __device__ __forceinline__ int lds_byte(int r, int c) { const int st = (r >> 4) * 2 + (c >> 5), rr = r & 15, cc = c & 31, ob = rr * 64 + cc * 2; return st * 1024 + (ob ^ (((ob >> 9) & 1) << 5)); }
__host__ __device__ __forceinline__ void stage_rc(int b, int& R, int& C) { const int st = b / 1024, sb = b % 1024, swz = sb ^ (((sb >> 9) & 1) << 5); R = (st >> 1) * 16 + swz / 64; C = (st & 1) * 32 + (swz % 64) / 2; }
__host__ __device__ __forceinline__ int perm32(int rho) { const int n = rho >> 4, i = rho & 15; return 8 * (i >> 2) + 4 * n + (i & 3); }
struct Unit { const char* a; const char* b; int nt, pm, pn, mode, ksi; };
struct Gemm { int ld; };
struct Seg { const char* a; const char* b; int nM, nN, ks, nt, mode, count; };
struct SegOrder {
    Seg s0, s1; int nseg, G, c; size_t tstep;
    __device__ __forceinline__ void init(int ld, int G_, int c_) { G = G_; c = c_; tstep = (size_t)BM * ld * 2; nseg = 0; s1.count = 0; }
    __device__ __forceinline__ void add(const void* a, const void* b, int nM, int nN, int ks, int nt, int mode) {
        Seg q; q.a = (const char*)a; q.b = (const char*)b; q.nM = nM; q.nN = nN; q.ks = ks; q.nt = nt; q.mode = mode; q.count = nM * nN * ks;
        if (nseg == 0) s0 = q; else s1 = q; ++nseg; }
    __device__ __forceinline__ bool next(int i, Unit& u) const {
        long L = (long)i * G + c; bool second = false;
        if (L >= s0.count) { L -= s0.count; second = true; if (L >= s1.count) return false; }
        const char* qa = second ? s1.a : s0.a; const char* qb = second ? s1.b : s0.b;
        const int nM = second ? s1.nM : s0.nM, nN = second ? s1.nN : s0.nN, ks = second ? s1.ks : s0.ks, qnt = second ? s1.nt : s0.nt, mode = second ? s1.mode : s0.mode;
        const int ksi = (int)(L % ks); int wgid = (int)(L / ks); const int nwg = nM * nN;
        { const int qq = nwg / NXCD, r = nwg % NXCD, xcd = wgid % NXCD, off = wgid / NXCD; wgid = (xcd < r ? xcd * (qq + 1) : r * (qq + 1) + (xcd - r) * qq) + off; }
        const int nig = WGM * nN, gid = wgid / nig, fm = gid * WGM, gsz = (nM - fm) < WGM ? (nM - fm) : WGM;
        u.pm = fm + ((wgid % nig) % gsz); u.pn = (wgid % nig) / gsz; u.nt = qnt; u.mode = mode; u.ksi = ksi;
        const size_t koff = (size_t)ksi * qnt * (BK * 2);
        u.a = qa + (size_t)u.pm * tstep + koff; u.b = qb + (size_t)u.pn * tstep + koff; return true;
    }
    __device__ __forceinline__ void a_ready(const Unit&) const {}
    __device__ __forceinline__ void done(const Unit&) const {}
};
__device__ __forceinline__ unsigned cvt_pk_bf16(float lo, float hi) { return pk2(lo, hi); }

struct EpiBf16 {
    static constexpr bool PERM = true, AFTER_DRAIN = false;
    bf16_t* O0; int ldc0; bf16_t* O1; int ldc1; int ACT;
    __device__ __forceinline__ void operator()(const f32x4 (&acc)[2][2][4][2], const Unit& u, int wr, int wc, int fr, int fq) const {
        const int row0 = u.pm * BM + wr * 64 + fr; const int col0 = u.pn * BM + wc * 32 + 8 * fq;
        bf16_t* O = u.mode ? O1 : O0; const int ldc = u.mode ? ldc1 : ldc0;
#pragma unroll
        for (int ai = 0; ai < 2; ++ai)
#pragma unroll
            for (int m = 0; m < 4; ++m) { bf16_t* rowp = O + (size_t)(row0 + ai * HALF + m * 16) * ldc + col0;
#pragma unroll
                for (int bj = 0; bj < 2; ++bj) { f32x4 v0 = acc[ai][bj][m][0], v1 = acc[ai][bj][m][1];
                    if (ACT == 1) {
#pragma unroll
                        for (int e = 0; e < 4; ++e) { float a = fmaxf(v0[e], 0.f), b = fmaxf(v1[e], 0.f); v0[e] = a * a; v1[e] = b * b; } }
                    u32x4 w; w.x = cvt_pk_bf16(v0[0], v0[1]); w.y = cvt_pk_bf16(v0[2], v0[3]); w.z = cvt_pk_bf16(v1[0], v1[1]); w.w = cvt_pk_bf16(v1[2], v1[3]);
                    *(u32x4*)(rowp + bj * HALF) = w; } }
    }
};
struct EpiResid {
    static constexpr bool PERM = false, AFTER_DRAIN = false;
    const float* base_lat; float* out_lat; float* out_ctx; const float* gate;
    __device__ __forceinline__ void operator()(const f32x4 (&acc)[2][2][4][2], const Unit& u, int wr, int wc, int fr, int fq) const {
        const bool isl = u.mode == 0;
        const int bidx = isl ? (u.pm >> 4) : 4;
        const float* gp = gate + (size_t)bidx * (6 * D) + u.pn * BM + wc * 32 + 4 * fq;
        const size_t eoff = ((size_t)u.pm * BM + wr * 64 + fr) * D + u.pn * BM + wc * 32 + 4 * fq;
        f32x4 gv[2][2];
#pragma unroll
        for (int bj = 0; bj < 2; ++bj)
#pragma unroll
            for (int n = 0; n < 2; ++n) gv[bj][n] = *(const f32x4*)(gp + bj * HALF + n * 16);
        if (isl) {
            const float* bp = base_lat + eoff; float* op = out_lat + eoff;
#pragma unroll
            for (int ai = 0; ai < 2; ++ai) {
                f32x4 bs[4][2][2];
#pragma unroll
                for (int m = 0; m < 4; ++m)
#pragma unroll
                    for (int bj = 0; bj < 2; ++bj)
#pragma unroll
                        for (int n = 0; n < 2; ++n) bs[m][bj][n] = *(const f32x4*)(bp + (size_t)(ai * HALF + m * 16) * D + bj * HALF + n * 16);
                asm volatile("" ::: "memory");
#pragma unroll
                for (int m = 0; m < 4; ++m)
#pragma unroll
                    for (int bj = 0; bj < 2; ++bj)
#pragma unroll
                        for (int n = 0; n < 2; ++n) *(f32x4*)(op + (size_t)(ai * HALF + m * 16) * D + bj * HALF + n * 16) = bs[m][bj][n] + gv[bj][n] * acc[ai][bj][m][n];
                asm volatile("" ::: "memory");
            }
        } else {
            float* op = out_ctx + (size_t)u.ksi * MCTX * D + eoff;
#pragma unroll
            for (int ai = 0; ai < 2; ++ai)
#pragma unroll
                for (int m = 0; m < 4; ++m) { const size_t off = (size_t)(ai * HALF + m * 16) * D;
#pragma unroll
                    for (int bj = 0; bj < 2; ++bj)
#pragma unroll
                        for (int n = 0; n < 2; ++n) *(f32x4*)(op + off + bj * HALF + n * 16) = acc[ai][bj][m][n]; }
        }
    }
};

template <class Epi, class Sched, bool ALIGN_EPI = false, bool SP2 = false>
__device__ __forceinline__ void gemm_phase(LAS unsigned char* lds, const Gemm g, const Sched& S, const Epi& E) {
    const int tid = threadIdx.x, wid = __builtin_amdgcn_readfirstlane(tid >> 6), lane = tid & 63, wr = wid >> 2, wc = wid & 3, fr = lane & 15, fq = lane >> 4;
    const int K = g.ld;
    unsigned voffA[2], voffB[2];
#pragma unroll
    for (int i = 0; i < 2; ++i) { int R, C; stage_rc(tid * 16 + i * 8192, R, C); const int Rb = Epi::PERM ? ((R & ~31) + perm32(R & 31)) : R;
        voffA[i] = (unsigned)(R * K + C) * 2u; voffB[i] = (unsigned)(Rb * K + C) * 2u; }
    const size_t kstep = (size_t)(BK * 2);
    const size_t hstep = (size_t)HALF * K * 2;
    const unsigned ldsw = (unsigned)wid * 1024u;
    const int aoff = lds_byte(wr * 64 + fr, fq * 8), boff = lds_byte(wc * 32 + fr, fq * 8);
#define PG8_SA(b, h) (((b) * 2 + (h)) * HTB)
#define PG8_SB(b, h) ((4 + (b) * 2 + (h)) * HTB)
#define PG8_STAGE(bufoff, gbase, voff) do { _Pragma("unroll") for (int _i = 0; _i < 2; ++_i) \
        __builtin_amdgcn_global_load_lds((const unsigned*)((const char*)(gbase) + (voff)[_i]), (LAS unsigned*)(lds + (bufoff) + ldsw + _i * 8192), 16, 0, 0); } while (0)
#define PG8_LDA(dst, b, h) do { _Pragma("unroll") for (int m = 0; m < 4; ++m) _Pragma("unroll") for (int k = 0; k < 2; ++k) dst[m][k] = *(const LAS bf16x8*)(lds + PG8_SA(b, h) + aoff + m * 2048 + k * 1024); } while (0)
#define PG8_LDB(dst, b, h) do { _Pragma("unroll") for (int n = 0; n < 2; ++n) _Pragma("unroll") for (int k = 0; k < 2; ++k) dst[n][k] = *(const LAS bf16x8*)(lds + PG8_SB(b, h) + boff + n * 2048 + k * 1024); } while (0)
#define PG8_MMA(ai, bj, At, Bt) do { __builtin_amdgcn_s_setprio(1); _Pragma("unroll") for (int m = 0; m < 4; ++m) _Pragma("unroll") for (int n = 0; n < 2; ++n) _Pragma("unroll") for (int k = 0; k < 2; ++k) \
        acc[ai][bj][m][n] = __builtin_amdgcn_mfma_f32_16x16x32_bf16(Bt[n][k], At[m][k], acc[ai][bj][m][n], 0, 0, 0); __builtin_amdgcn_s_setprio(0); } while (0)
#define PG8_WAIT_V(n) asm volatile("s_waitcnt vmcnt(" #n ")" ::: "memory")
#define PG8_WAIT_L(n) asm volatile("s_waitcnt lgkmcnt(" #n ")" ::: "memory")
#define PG8_BAR __builtin_amdgcn_s_barrier()
#define PG8_SCHED __builtin_amdgcn_sched_barrier(0)
    Unit cur, nxt; int ui = 0;
    if (!S.next(0, cur)) return;
    f32x4 acc[2][2][4][2];
#pragma unroll
    for (int a = 0; a < 2; ++a)
#pragma unroll
        for (int b = 0; b < 2; ++b)
#pragma unroll
            for (int m = 0; m < 4; ++m)
#pragma unroll
                for (int n = 0; n < 2; ++n) acc[a][b][m][n] = (f32x4){0.f, 0.f, 0.f, 0.f};
    bf16x8 At[4][2], B0[2][2], B1[2][2];
    const char* cA = cur.a; const char* cB = cur.b;
    S.a_ready(cur);
    if constexpr (SP2) {
        PG8_STAGE(PG8_SB(0, 0), cB, voffB); PG8_STAGE(PG8_SB(0, 1), cB + hstep, voffB); PG8_STAGE(PG8_SA(0, 0), cA, voffA); PG8_STAGE(PG8_SA(0, 1), cA + hstep, voffA);
        if (wr == 1) PG8_BAR;
        PG8_WAIT_V(2); PG8_BAR;
        PG8_STAGE(PG8_SB(1, 0), cB + kstep, voffB); PG8_STAGE(PG8_SA(1, 0), cA + kstep, voffA); PG8_STAGE(PG8_SB(1, 1), cB + hstep + kstep, voffB);
        PG8_WAIT_V(6); PG8_BAR;
    } else {
        PG8_STAGE(PG8_SB(0, 0), cB, voffB); PG8_STAGE(PG8_SA(0, 0), cA, voffA); PG8_STAGE(PG8_SB(0, 1), cB + hstep, voffB); PG8_STAGE(PG8_SA(0, 1), cA + hstep, voffA);
        if (wr == 1) PG8_BAR;
        PG8_WAIT_V(4); PG8_BAR;
        PG8_STAGE(PG8_SB(1, 0), cB + kstep, voffB); PG8_STAGE(PG8_SA(1, 0), cA + kstep, voffA); PG8_STAGE(PG8_SB(1, 1), cB + hstep + kstep, voffB);
        PG8_WAIT_V(6); PG8_BAR;
    }
    for (;;) {
        const bool has_next = S.next(ui + 1, nxt);
        const char* nA = has_next ? nxt.a : cA; const char* nB = has_next ? nxt.b : cB;
        const int nt = cur.nt;
        for (int t = 0; t < nt; t += 2) {
            const bool last = (t == nt - 2);
            const char* a1 = cA + (size_t)(t + 1) * kstep;
            const char* a2 = last ? nA : cA + (size_t)(t + 2) * kstep; const char* b2 = last ? nB : cB + (size_t)(t + 2) * kstep;
            const char* a3 = a2 + kstep; const char* b3 = b2 + kstep;
            if (last && has_next) S.a_ready(nxt);
            if constexpr (SP2) {
            PG8_LDB(B0, 0, 0); PG8_LDB(B1, 0, 1); PG8_SCHED; PG8_LDA(At, 0, 0); PG8_STAGE(PG8_SA(1, 1), a1 + hstep, voffA);
            PG8_WAIT_V(8); PG8_WAIT_L(0); PG8_BAR; PG8_MMA(0, 0, At, B0); PG8_MMA(0, 1, At, B1); PG8_BAR; PG8_SCHED;
            PG8_LDA(At, 0, 1); PG8_STAGE(PG8_SB(0, 0), b2, voffB); PG8_STAGE(PG8_SB(0, 1), b2 + hstep, voffB); PG8_STAGE(PG8_SA(0, 0), a2, voffA);
            PG8_WAIT_V(8); PG8_WAIT_L(0); PG8_BAR; PG8_MMA(1, 0, At, B0); PG8_MMA(1, 1, At, B1); PG8_BAR; PG8_SCHED;
            PG8_LDB(B0, 1, 0); PG8_LDB(B1, 1, 1); PG8_SCHED; PG8_LDA(At, 1, 0); PG8_STAGE(PG8_SA(0, 1), a2 + hstep, voffA);
            PG8_WAIT_V(8); PG8_WAIT_L(0); PG8_BAR; PG8_MMA(0, 0, At, B0); PG8_MMA(0, 1, At, B1); PG8_BAR; PG8_SCHED;
            PG8_LDA(At, 1, 1); PG8_STAGE(PG8_SB(1, 0), b3, voffB); PG8_STAGE(PG8_SB(1, 1), b3 + hstep, voffB); PG8_STAGE(PG8_SA(1, 0), a3, voffA);
            PG8_WAIT_V(8); PG8_WAIT_L(0); PG8_BAR; PG8_MMA(1, 0, At, B0); PG8_MMA(1, 1, At, B1); PG8_BAR; PG8_SCHED;
            } else {
            PG8_LDB(B0, 0, 0); PG8_SCHED; PG8_LDA(At, 0, 0); PG8_STAGE(PG8_SA(1, 1), a1 + hstep, voffA);
            PG8_WAIT_L(8); PG8_BAR; PG8_WAIT_L(0); PG8_MMA(0, 0, At, B0); PG8_BAR; PG8_SCHED;
            PG8_LDB(B1, 0, 1); PG8_STAGE(PG8_SB(0, 0), b2, voffB);
            PG8_BAR; PG8_WAIT_L(0); PG8_MMA(0, 1, At, B1); PG8_BAR;
            PG8_LDA(At, 0, 1); PG8_STAGE(PG8_SA(0, 0), a2, voffA);
            PG8_BAR; PG8_WAIT_L(0); PG8_MMA(1, 0, At, B0); PG8_BAR; PG8_SCHED;
            PG8_STAGE(PG8_SB(0, 1), b2 + hstep, voffB);
            PG8_WAIT_V(6); PG8_BAR; PG8_MMA(1, 1, At, B1); PG8_BAR;
            PG8_LDB(B0, 1, 0); PG8_SCHED; PG8_LDA(At, 1, 0); PG8_STAGE(PG8_SA(0, 1), a2 + hstep, voffA);
            PG8_WAIT_L(8); PG8_BAR; PG8_WAIT_L(0); PG8_MMA(0, 0, At, B0); PG8_BAR; PG8_SCHED;
            PG8_LDB(B1, 1, 1); PG8_STAGE(PG8_SB(1, 0), b3, voffB);
            PG8_BAR; PG8_WAIT_L(0); PG8_MMA(0, 1, At, B1); PG8_BAR;
            PG8_LDA(At, 1, 1); PG8_STAGE(PG8_SA(1, 0), a3, voffA);
            PG8_BAR; PG8_WAIT_L(0); PG8_MMA(1, 0, At, B0); PG8_BAR; PG8_SCHED;
            PG8_STAGE(PG8_SB(1, 1), b3 + hstep, voffB);
            PG8_WAIT_V(6); PG8_BAR; PG8_MMA(1, 1, At, B1); PG8_BAR;
            }
        }
        if constexpr (ALIGN_EPI) { if (wr == 0) PG8_BAR; }
        if constexpr (!Epi::AFTER_DRAIN) { E(acc, cur, wr, wc, fr, fq); S.done(cur); }
        if (!has_next) break;
#pragma unroll
        for (int a = 0; a < 2; ++a)
#pragma unroll
            for (int b = 0; b < 2; ++b)
#pragma unroll
                for (int m = 0; m < 4; ++m)
#pragma unroll
                    for (int n = 0; n < 2; ++n) acc[a][b][m][n] = (f32x4){0.f, 0.f, 0.f, 0.f};
        cur = nxt; cA = nA; cB = nB; ++ui;
        if constexpr (ALIGN_EPI) { if (wr == 1) PG8_BAR; }
    }
    PG8_WAIT_V(0);
    if constexpr (!ALIGN_EPI) { if (wr == 0) PG8_BAR; }
    PG8_BAR;
#undef PG8_SA
#undef PG8_SB
#undef PG8_STAGE
#undef PG8_LDA
#undef PG8_LDB
#undef PG8_MMA
#undef PG8_WAIT_V
#undef PG8_WAIT_L
#undef PG8_BAR
#undef PG8_SCHED
}
}

__device__ __forceinline__ void phase_mod(const Params& p, unsigned char* lds, const int layer, const int wb0, const int nwb) {
    const int tid = threadIdx.x;
    float* sc = (float*)lds;
    float* red = (float*)(lds + 40960);
    float* modv = (float*)(p.ws + WS_MODV);
    __syncthreads();
    for (int e = tid; e < 5 * D; e += 512) { const int r = e / D, k = e % D; const float v = r < 4 ? p.c[r * D + k] : p.c_ctx[k]; sc[e] = siluf_(v); }
    __syncthreads();
    for (int it = (int)blockIdx.x - wb0; it < 256; it += nwb) {
        const int l = layer, n0 = it * 48;
        const int kg = tid / 12, cg_ = tid % 12;
        float acc[5][4];
#pragma unroll
        for (int r = 0; r < 5; ++r)
#pragma unroll
            for (int j = 0; j < 4; ++j) acc[r][j] = 0.f;
        if (kg < 42) {
            const float* wp = p.mod_w + (size_t)l * D * (6 * D) + n0 + 4 * cg_;
#pragma unroll 4
            for (int k = kg; k < D; k += 42) {
                const f32x4 w = *(const f32x4*)(wp + (size_t)k * (6 * D));
#pragma unroll
                for (int r = 0; r < 5; ++r) { const float s = sc[r * D + k];
#pragma unroll
                    for (int j = 0; j < 4; ++j) acc[r][j] += s * w[j]; }
            }
#pragma unroll
            for (int r = 0; r < 5; ++r)
#pragma unroll
                for (int j = 0; j < 4; ++j) red[(kg * 5 + r) * 48 + 4 * cg_ + j] = acc[r][j];
        }
        __syncthreads();
        if (tid < 240) { const int r = tid / 48, n = tid % 48; float s = p.mod_b[l * (6 * D) + n0 + n];
            for (int q = 0; q < 42; ++q) s += red[(q * 5 + r) * 48 + n];
            modv[((size_t)l * 5 + r) * (6 * D) + n0 + n] = s; }
        __syncthreads();
    }
    if (layer == 0 && blockIdx.x == gridDim.x - 1) {
        f32x2* tab = (f32x2*)(p.ws + WS_ROPE);
        for (int e = tid; e < 64 * 32; e += 512) { const int pos = e >> 5, i = e & 31;
            const float inv = exp2f(-(float)i * (13.287712379549449f / 32.f));
            const float ang = (float)pos * inv;
            tab[e] = (f32x2){__cosf(ang), __sinf(ang)}; }
    }
}

__device__ __forceinline__ void transpose_item(const float* W, int K, int N, bf16_t* WT, int kb, int n0, int dst_n0, float* scr, int lane) {
    const int k0 = 64 * kb;
    float wv[32];
#pragma unroll
    for (int i = 0; i < 32; ++i) wv[i] = W[(size_t)(k0 + 2 * i + (lane >> 5)) * N + n0 + (lane & 31)];
#pragma unroll
    for (int i = 0; i < 32; ++i) scr[(2 * i + (lane >> 5)) * 33 + (lane & 31)] = wv[i];
    asm volatile("s_waitcnt lgkmcnt(0)" ::: "memory");
    const int c = lane & 7;
#pragma unroll
    for (int j = 0; j < 4; ++j) { const int n = (lane >> 3) + 8 * j; const float* s = scr + (8 * c) * 33 + n;
        u32x4 o; o.x = pk2(s[0 * 33], s[1 * 33]); o.y = pk2(s[2 * 33], s[3 * 33]); o.z = pk2(s[4 * 33], s[5 * 33]); o.w = pk2(s[6 * 33], s[7 * 33]);
        *(u32x4*)(WT + (size_t)(dst_n0 + n) * K + k0 + 8 * c) = o; }
    asm volatile("s_waitcnt lgkmcnt(0)" ::: "memory");
}
__device__ __forceinline__ void modulate_row(const float* xr, const float* g, const float* shift, const float* scale, bf16_t* dst, int lane, const float* part, const float* cgate, float* xw) {
    f32x4 v[8]; float ss = 0.f;
#pragma unroll
    for (int j = 0; j < 8; ++j) { const int c = 256 * j + 4 * lane; v[j] = *(const f32x4*)(xr + c);
        if (part) { f32x4 a = *(const f32x4*)(part + c);
#pragma unroll
            for (int sp = 1; sp < 8; ++sp) a += *(const f32x4*)(part + (size_t)sp * MCTX * D + c);
            v[j] += *(const f32x4*)(cgate + c) * a; *(f32x4*)(xw + c) = v[j]; }
        ss += (v[j].x * v[j].x + v[j].y * v[j].y) + (v[j].z * v[j].z + v[j].w * v[j].w); }
    const float rstd = rsqrtf(wave_sum(ss) * (1.f / D) + EPS);
#pragma unroll
    for (int j = 0; j < 8; ++j) { const int c = 256 * j + 4 * lane;
        const f32x4 gg = *(const f32x4*)(g + c), sh = *(const f32x4*)(shift + c), sc = *(const f32x4*)(scale + c);
        const f32x4 o = v[j] * rstd * gg * (sc + 1.f) + sh;
        u32x2 w; w.x = pk2(o.x, o.y); w.y = pk2(o.z, o.w); *(u32x2*)(dst + c) = w; }
}
__device__ __forceinline__ void modulate_rows2(const float* x0, const float* x1, const float* g, const float* mv0, const float* mv1, bf16_t* d0, bf16_t* d1, int lane) {
    f32x4 v0[8], v1[8]; float s0 = 0.f, s1 = 0.f;
#pragma unroll
    for (int j = 0; j < 8; ++j) { v0[j] = *(const f32x4*)(x0 + 256 * j + 4 * lane); v1[j] = *(const f32x4*)(x1 + 256 * j + 4 * lane); }
#pragma unroll
    for (int j = 0; j < 8; ++j) { s0 += (v0[j].x * v0[j].x + v0[j].y * v0[j].y) + (v0[j].z * v0[j].z + v0[j].w * v0[j].w); s1 += (v1[j].x * v1[j].x + v1[j].y * v1[j].y) + (v1[j].z * v1[j].z + v1[j].w * v1[j].w); }
    const float r0 = rsqrtf(wave_sum(s0) * (1.f / D) + EPS), r1 = rsqrtf(wave_sum(s1) * (1.f / D) + EPS);
#pragma unroll
    for (int j = 0; j < 8; ++j) { const int c = 256 * j + 4 * lane;
        const f32x4 gg = *(const f32x4*)(g + c);
        const f32x4 o0 = v0[j] * r0 * gg * (*(const f32x4*)(mv0 + D + c) + 1.f) + *(const f32x4*)(mv0 + c);
        const f32x4 o1 = v1[j] * r1 * gg * (*(const f32x4*)(mv1 + D + c) + 1.f) + *(const f32x4*)(mv1 + c);
        *(u32x2*)(d0 + c) = (u32x2){pk2(o0.x, o0.y), pk2(o0.z, o0.w)}; *(u32x2*)(d1 + c) = (u32x2){pk2(o1.x, o1.y), pk2(o1.z, o1.w)}; }
}
__device__ __forceinline__ void phase_modulate(const Params& p, const float* xl, const float* xc, const float* g, int layer, int which, int nrows, int cslot, int clayer) {
    const int lane = threadIdx.x & 63, gw = blockIdx.x * 8 + (threadIdx.x >> 6), NGW = gridDim.x * 8;
    const float* modv = (const float*)(p.ws + WS_MODV) + (size_t)layer * 5 * (6 * D);
    const float* cgate = (const float*)(p.ws + WS_MODV) + ((size_t)clayer * 5 + 4) * (6 * D) + (cslot < 0 ? 0 : cslot) * D;
    bf16_t* A = (bf16_t*)(p.ws + WS_A);
    int m = gw;
    for (; m + NGW < MLAT && m + NGW < nrows; m += 2 * NGW) {
        const int m1 = m + NGW;
        const float* mv0 = modv + (size_t)(m >> 12) * (6 * D) + which * 3 * D; const float* mv1 = modv + (size_t)(m1 >> 12) * (6 * D) + which * 3 * D;
        modulate_rows2(xl + (size_t)m * D, xl + (size_t)m1 * D, g, mv0, mv1, A + (size_t)m * D, A + (size_t)m1 * D, lane);
    }
    for (; m < nrows; m += NGW) {
        const bool isl = m < MLAT; const int bidx = isl ? (m >> 12) : 4;
        const float* xr = isl ? xl + (size_t)m * D : xc + (size_t)(m - MLAT) * D;
        const float* mv = modv + (size_t)bidx * (6 * D) + which * 3 * D;
        const float* part = (!isl && cslot >= 0) ? (const float*)(p.ws + WS_PART) + (size_t)(m - MLAT) * D : nullptr;
        float* xw = (float*)(p.ws + WS_XC) + (size_t)(isl ? 0 : m - MLAT) * D;
        modulate_row(xr, g, mv, mv + D, A + (size_t)m * D, lane, part, cgate, xw);
    }
}
__device__ __forceinline__ void phase_convert(const Params& p, unsigned char* lds, const int part, const int wb0, const int nwb) {
    const int lane = threadIdx.x & 63, wave = threadIdx.x >> 6;
    float* scr = (float*)(lds + wave * 16384);
    const int gw = ((int)blockIdx.x - wb0) * 8 + wave, NGW = nwb * 8;
    constexpr int I_IN = 32 * 161, I_OUT = 32 * 64, I_UP = 32 * 256, I_DN = 128 * 64, I_QKV = 32 * 192, I_NO = 32 * 64;
    bf16_t* win = (bf16_t*)(p.ws + WS_WIN); bf16_t* wout = (bf16_t*)(p.ws + WS_WOUT); bf16_t* wup = (bf16_t*)(p.ws + WS_WUP);
    bf16_t* wdn = (bf16_t*)(p.ws + WS_WDN); bf16_t* wqkv = (bf16_t*)(p.ws + WS_WQKV); bf16_t* wno = (bf16_t*)(p.ws + WS_WNO);
    __syncthreads();
    if (part == 0) {
        for (int it = gw; it < I_IN + I_OUT + I_UP + I_DN; it += NGW) {
            int r = it;
            if (r < I_IN) { const int kb = r / 161, nb = r % 161, n0 = 32 * nb;
                if (n0 >= 1024 && n0 < 2048) { transpose_item(p.ev_w_in, D, 5152, (bf16_t*)(p.ws + WS_WV0), kb, n0, n0 - 1024, scr, lane); continue; }
                const int dn = n0 < 1024 ? n0 : (n0 < 3072 ? n0 - 1024 : (n0 == 3072 ? C_GL : (n0 < 4128 ? n0 - 3104 + C_XR : n0 - 4128 + C_YR)));
                transpose_item(p.ev_w_in, D, 5152, win, kb, n0, dn, scr, lane); continue; } r -= I_IN;
            if (r < I_OUT) { transpose_item(p.ev_w_out, D, D, wout, r / 64, 32 * (r % 64), 32 * (r % 64), scr, lane); continue; } r -= I_OUT;
            if (r < I_UP) { transpose_item(p.mlp_up, D, DFF, wup, r / 256, 32 * (r % 256), 32 * (r % 256), scr, lane); continue; } r -= I_UP;
            transpose_item(p.mlp_down, DFF, D, wdn, r / 64, 32 * (r % 64), 32 * (r % 64), scr, lane);
        }
        for (int m = (int)blockIdx.x - wb0; m < 32; m += nwb) { const float* src = ((m & 1) ? p.w_x : p.w_a) + (size_t)(m >> 1) * 16384; bf16_t* img = (bf16_t*)(p.ws + WS_LRUW) + (size_t)m * (128 * 136);
            for (int e = threadIdx.x; e < 16384; e += 512) { const int ii = e >> 7, j = e & 127; img[j * 136 + ii] = (bf16_t)f2bf(src[e]); }
            for (int e = threadIdx.x; e < 128 * 8; e += 512) img[(e >> 3) * 136 + 128 + (e & 7)] = (bf16_t)0; }
        u32x4* z = (u32x4*)(win + (size_t)4128 * D); const int nz = (NIN - 4128) * D * 2 / 16;
        for (int e = ((int)blockIdx.x - wb0) * 512 + threadIdx.x; e < nz; e += nwb * 512) z[e] = (u32x4){0u, 0u, 0u, 0u};
    } else {
        for (int it = gw; it < I_UP + I_DN + I_QKV + I_NO; it += NGW) {
            int r = it;
            if (r < I_UP) { transpose_item(p.mlp_up + (size_t)D * DFF, D, DFF, wup + (size_t)D * DFF, r / 256, 32 * (r % 256), 32 * (r % 256), scr, lane); continue; } r -= I_UP;
            if (r < I_DN) { transpose_item(p.mlp_down + (size_t)D * DFF, DFF, D, wdn + (size_t)D * DFF, r / 64, 32 * (r % 64), 32 * (r % 64), scr, lane); continue; } r -= I_DN;
            if (r < I_QKV) { transpose_item(p.na_qkv, D, NQKV, wqkv, r / 192, 32 * (r % 192), 32 * (r % 192), scr, lane); continue; } r -= I_QKV;
            transpose_item(p.na_out, D, D, wno, r / 64, 32 * (r % 64), 32 * (r % 64), scr, lane);
        }
    }
    __syncthreads();
}

constexpr int GL_GU = 0, GL_GB = 8192, GL_TAB = 8704, GL_GBUF = 25088, GL_TOT = 58880, GL_BLE = 60928, GL_QE = 61440, GL_KE = 78848, GL_VT = 96256, GL_ATT = 105472, GL_ST = 114688, GL_END = 132096;
static_assert(GL_END <= LDS_BYTES, "gla lds");
#define GLA_ROW(ci, ii, row, tok, isl) do { isl = (ci) >= 4; const int cc_ = isl ? (ci) - 4 : (ci); const int n_ = isl ? SEQ : CTX; const int pos_ = cc_ * 64 + (ii); \
        tok = dir ? n_ - 1 - pos_ : pos_; row = isl ? (size_t)b * SEQ + tok : (size_t)MLAT + b * CTX + tok; } while (0)
__device__ __forceinline__ void gla_pre(const Params& p, unsigned char* lds) {
    const int tid = threadIdx.x, lane = tid & 63, w = __builtin_amdgcn_readfirstlane(tid >> 6);
    float* gu = (float*)(lds + GL_GU); float* gbv = (float*)(lds + GL_GB); f32x2* tab = (f32x2*)(lds + GL_TAB);
    float* gbuf = (float*)(lds + GL_GBUF); float* tot = (float*)(lds + GL_TOT);
    bf16_t* qe = (bf16_t*)(lds + GL_QE); bf16_t* ke = (bf16_t*)(lds + GL_KE); bf16_t* att = (bf16_t*)(lds + GL_ATT);
    const bf16_t* P = (const bf16_t*)(p.ws + WS_P);
    bf16_t* GQ = (bf16_t*)(p.ws + WS_GQ); bf16_t* GK = (bf16_t*)(p.ws + WS_GK); bf16_t* GA = (bf16_t*)(p.ws + WS_GATT); float* GE = (float*)(p.ws + WS_GBLE);
    const int i = tid >> 3, dg = tid & 7;
    const int fr = lane & 15, fq = lane >> 4;
    __syncthreads();
    { const f32x2* rt = (const f32x2*)(p.ws + WS_ROPE); for (int e = tid; e < 2048; e += 512) tab[e] = rt[e]; }
    for (int it = blockIdx.x; it < 32 * 68; it += gridDim.x) {
        const int chain = it / 68, ci = it % 68; const int dir = chain & 1, h = (chain >> 1) & 3, b = chain >> 3;
        __syncthreads();
        for (int e = tid; e < 2048; e += 512) { const int r = e >> 7, d = e & 127; gu[e] = p.gate_up[(dir * 16 + r) * 512 + h * 128 + d]; }
        if (tid < 128) gbv[tid] = p.gate_b[dir * 512 + h * 128 + tid];
        bool isl; int tok; size_t row; GLA_ROW(ci, i, row, tok, isl);
        const bf16_t* pr = P + row * NIN;
        const u32x4 rq0 = *(const u32x4*)(pr + C_Q + h * 128 + dg * 16), rq1 = *(const u32x4*)(pr + C_Q + h * 128 + dg * 16 + 8);
        const u32x4 rqp0 = *(const u32x4*)(pr + C_Q + h * 128 + (dg ^ 2) * 16), rqp1 = *(const u32x4*)(pr + C_Q + h * 128 + (dg ^ 2) * 16 + 8);
        const u32x4 rk0 = *(const u32x4*)(pr + C_K + h * 128 + dg * 16), rk1 = *(const u32x4*)(pr + C_K + h * 128 + dg * 16 + 8);
        const u32x4 rkp0 = *(const u32x4*)(pr + C_K + h * 128 + (dg ^ 2) * 16), rkp1 = *(const u32x4*)(pr + C_K + h * 128 + (dg ^ 2) * 16 + 8);
        const u32x4 rg0 = *(const u32x4*)(pr + C_GL + dir * 16), rg1 = *(const u32x4*)(pr + C_GL + dir * 16 + 8);
        __syncthreads();
        {
            float gl[16]; unpack8(rg0, gl); unpack8(rg1, gl + 8);
            float z[16];
#pragma unroll
            for (int j = 0; j < 16; ++j) z[j] = gbv[dg * 16 + j];
#pragma unroll
            for (int r = 0; r < 16; ++r) {
#pragma unroll
                for (int j4 = 0; j4 < 4; ++j4) { const f32x4 u4 = *(const f32x4*)(gu + r * 128 + dg * 16 + 4 * j4);
                    z[4 * j4 + 0] += gl[r] * u4.x; z[4 * j4 + 1] += gl[r] * u4.y; z[4 * j4 + 2] += gl[r] * u4.z; z[4 * j4 + 3] += gl[r] * u4.w; }
            }
#pragma unroll
            for (int j4 = 0; j4 < 4; ++j4) { f32x4 o; o.x = logsigf_(z[4 * j4]) * 0.0625f; o.y = logsigf_(z[4 * j4 + 1]) * 0.0625f; o.z = logsigf_(z[4 * j4 + 2]) * 0.0625f; o.w = logsigf_(z[4 * j4 + 3]) * 0.0625f;
                *(f32x4*)(gbuf + i * 132 + dg * 16 + 4 * j4) = o; }
        }
        __syncthreads();
        { const int d = tid & 127, seg = tid >> 7; float run = 0.f;
#pragma unroll
          for (int ii = 0; ii < 16; ++ii) { float* gp = gbuf + (seg * 16 + ii) * 132 + d; run += *gp; *gp = run; }
          tot[seg * 128 + d] = run; }
        __syncthreads();
        {
            const int seg = i >> 4;
            float q[16], qp[16], k[16], kp[16];
            unpack8(rq0, q); unpack8(rq1, q + 8); unpack8(rqp0, qp); unpack8(rqp1, qp + 8);
            unpack8(rk0, k); unpack8(rk1, k + 8); unpack8(rkp0, kp); unpack8(rkp1, kp + 8);
            const float qs = 0.08838834764831845f;
            if (isl) {
                const int posr = (dg < 4) ? (tok >> 6) : (tok & 63);
                const float sgn = (dg & 2) ? 1.f : -1.f;
                const f32x2* tp = tab + posr * 32 + (dg & 1) * 16;
#pragma unroll
                for (int j = 0; j < 16; ++j) { const f32x2 cs = tp[j];
                    q[j] = q[j] * cs.x + sgn * qp[j] * cs.y; k[j] = k[j] * cs.x + sgn * kp[j] * cs.y; }
            }
            unsigned qw[8], kw[8];
#pragma unroll
            for (int j2 = 0; j2 < 8; ++j2) {
                const int d0 = dg * 16 + 2 * j2;
                float b0 = gbuf[i * 132 + d0], b1 = gbuf[i * 132 + d0 + 1];
                if (seg > 0) { b0 += tot[d0]; b1 += tot[d0 + 1]; }
                if (seg > 1) { b0 += tot[128 + d0]; b1 += tot[128 + d0 + 1]; }
                if (seg > 2) { b0 += tot[256 + d0]; b1 += tot[256 + d0 + 1]; }
                const float e0 = __expf(b0), e1 = __expf(b1), n0 = __expf(-b0), n1 = __expf(-b1);
                if (i == 63) { GE[(size_t)it * 128 + d0] = e0; GE[(size_t)it * 128 + d0 + 1] = e1; }
                qw[j2] = pk2(q[2 * j2] * qs * e0, q[2 * j2 + 1] * qs * e1);
                kw[j2] = pk2(k[2 * j2] * n0, k[2 * j2 + 1] * n1);
            }
            const u32x4 q0 = (u32x4){qw[0], qw[1], qw[2], qw[3]}, q1 = (u32x4){qw[4], qw[5], qw[6], qw[7]}, k0 = (u32x4){kw[0], kw[1], kw[2], kw[3]}, k1 = (u32x4){kw[4], kw[5], kw[6], kw[7]};
            *(u32x4*)(qe + i * 136 + dg * 16) = q0; *(u32x4*)(qe + i * 136 + dg * 16 + 8) = q1;
            *(u32x4*)(ke + i * 136 + dg * 16) = k0; *(u32x4*)(ke + i * 136 + dg * 16 + 8) = k1;
            bf16_t* gq = GQ + (size_t)it * 8192 + i * 128 + dg * 16; bf16_t* gk = GK + (size_t)it * 8192 + i * 128 + dg * 16;
            *(u32x4*)gq = q0; *(u32x4*)(gq + 8) = q1; *(u32x4*)gk = k0; *(u32x4*)(gk + 8) = k1;
        }
        __syncthreads();
        {
            const int tr = w >> 1;
#pragma unroll
            for (int c2 = 0; c2 < 2; ++c2) { const int tc = (w & 1) * 2 + c2;
                f32x4 a = (f32x4){0.f, 0.f, 0.f, 0.f};
                if (tc <= tr) {
#pragma unroll
                    for (int ks = 0; ks < 4; ++ks) { const bf16x8 A = *(const bf16x8*)(qe + (tr * 16 + fr) * 136 + ks * 32 + fq * 8); const bf16x8 B = *(const bf16x8*)(ke + (tc * 16 + fr) * 136 + ks * 32 + fq * 8);
                        a = __builtin_amdgcn_mfma_f32_16x16x32_bf16(A, B, a, 0, 0, 0); }
                }
#pragma unroll
                for (int j = 0; j < 4; ++j) { const int t = tr * 16 + fq * 4 + j, s2 = tc * 16 + fr; const float v = (s2 <= t) ? a[j] : 0.f; att[t * 72 + s2] = (bf16_t)f2bf(v); }
            }
        }
        __syncthreads();
        { const int t = tid >> 3, c8 = tid & 7; *(u32x4*)(GA + (size_t)it * 4096 + t * 64 + c8 * 8) = *(const u32x4*)(att + t * 72 + c8 * 8); }
    }
    __syncthreads();
}
__device__ __forceinline__ void gla_seq(const Params& p, unsigned char* lds, int gb) {
    const int tid = threadIdx.x, lane = tid & 63, w = __builtin_amdgcn_readfirstlane(tid >> 6);
    const int dvs = gb & 3, dir = (gb >> 2) & 1, h = (gb >> 3) & 3, b = gb >> 5;
    const int chain = (b * 4 + h) * 2 + dir;
    float* blE = (float*)(lds + GL_BLE); float* ostg = (float*)(lds + GL_GBUF);
    bf16_t* qe = (bf16_t*)(lds + GL_QE); bf16_t* ke = (bf16_t*)(lds + GL_KE); bf16_t* vt = (bf16_t*)(lds + GL_VT);
    bf16_t* att = (bf16_t*)(lds + GL_ATT); bf16_t* St = (bf16_t*)(lds + GL_ST);
    const bf16_t* GQ = (const bf16_t*)(p.ws + WS_GQ) + (size_t)chain * 68 * 8192; const bf16_t* GK = (const bf16_t*)(p.ws + WS_GK) + (size_t)chain * 68 * 8192;
    const bf16_t* GA = (const bf16_t*)(p.ws + WS_GATT) + (size_t)chain * 68 * 4096; const float* GE = (const float*)(p.ws + WS_GBLE) + (size_t)chain * 68 * 128;
    bf16_t* obuf = (bf16_t*)(p.ws + (dir ? WS_OB : WS_OF));
    const int i = tid >> 3, dg = tid & 7;
    const int fr = lane & 15, fq = lane >> 4;
    const bf16_t* VT = (const bf16_t*)(p.ws + WS_VT) + (size_t)(h * 256 + dvs * 64 + i) * MALL;
    __syncthreads();
    for (int e = tid; e < 64 * 136 / 2; e += 512) ((unsigned*)St)[e] = 0u;
    f32x4 S[4];
#pragma unroll
    for (int q = 0; q < 4; ++q) S[q] = (f32x4){0.f, 0.f, 0.f, 0.f};
    u32x4 RA[6], RB[6]; float reA, reB;
#define GS_LOAD(R, re, ci) do { const bf16_t* gq = GQ + (size_t)(ci) * 8192 + i * 128 + dg * 16; const bf16_t* gk = GK + (size_t)(ci) * 8192 + i * 128 + dg * 16; \
        R[0] = *(const u32x4*)gq; R[1] = *(const u32x4*)(gq + 8); R[2] = *(const u32x4*)gk; R[3] = *(const u32x4*)(gk + 8); \
        R[4] = *(const u32x4*)(GA + (size_t)(ci) * 4096 + i * 64 + dg * 8); \
        { const bool isl_ = (ci) >= 4; const int cc2_ = isl_ ? (ci) - 4 : (ci); const int n2_ = isl_ ? SEQ : CTX; const int tlo_ = dir ? n2_ - 64 - cc2_ * 64 : cc2_ * 64; \
          R[5] = *(const u32x4*)(VT + (isl_ ? (size_t)b * SEQ : (size_t)MLAT + b * CTX) + tlo_ + 8 * dg); } \
        re = (tid < 128) ? GE[(size_t)(ci) * 128 + tid] : 0.f; } while (0)
#define GS_BODY(R, re, ci) do { \
        *(u32x4*)(qe + i * 136 + dg * 16) = R[0]; *(u32x4*)(qe + i * 136 + dg * 16 + 8) = R[1]; \
        *(u32x4*)(ke + i * 136 + dg * 16) = R[2]; *(u32x4*)(ke + i * 136 + dg * 16 + 8) = R[3]; \
        *(u32x4*)(att + i * 72 + dg * 8) = R[4]; \
        if (dir == 0) *(u32x4*)(vt + i * 72 + 8 * dg) = R[5]; \
        else { u32x4 o; o.x = (R[5].w >> 16) | (R[5].w << 16); o.y = (R[5].z >> 16) | (R[5].z << 16); o.z = (R[5].y >> 16) | (R[5].y << 16); o.w = (R[5].x >> 16) | (R[5].x << 16); *(u32x4*)(vt + i * 72 + 56 - 8 * dg) = o; } \
        if (tid < 128) blE[tid] = re; \
        if ((ci) + 2 < 68) GS_LOAD(R, re, (ci) + 2); \
        __syncthreads(); \
        { \
            const int tr = w >> 1; \
            _Pragma("unroll") for (int c2 = 0; c2 < 2; ++c2) { const int vc = (w & 1) * 2 + c2; \
                f32x4 a = (f32x4){0.f, 0.f, 0.f, 0.f}; \
                _Pragma("unroll") for (int ks = 0; ks < 4; ++ks) { const bf16x8 A = *(const bf16x8*)(qe + (tr * 16 + fr) * 136 + ks * 32 + fq * 8); const bf16x8 B = *(const bf16x8*)(St + (vc * 16 + fr) * 136 + ks * 32 + fq * 8); \
                    a = __builtin_amdgcn_mfma_f32_16x16x32_bf16(A, B, a, 0, 0, 0); } \
                _Pragma("unroll") for (int ks = 0; ks < 2; ++ks) { const bf16x8 A = *(const bf16x8*)(att + (tr * 16 + fr) * 72 + ks * 32 + fq * 8); const bf16x8 B = *(const bf16x8*)(vt + (vc * 16 + fr) * 72 + ks * 32 + fq * 8); \
                    a = __builtin_amdgcn_mfma_f32_16x16x32_bf16(A, B, a, 0, 0, 0); } \
                _Pragma("unroll") for (int j = 0; j < 4; ++j) ostg[(tr * 16 + fq * 4 + j) * 68 + vc * 16 + fr] = a[j]; \
            } \
            _Pragma("unroll") for (int ks = 0; ks < 2; ++ks) { \
                bf16x8 A; \
                _Pragma("unroll") for (int j = 0; j < 8; ++j) A[j] = (short)ke[(ks * 32 + fq * 8 + j) * 136 + 16 * w + fr]; \
                _Pragma("unroll") for (int vc = 0; vc < 4; ++vc) { const bf16x8 B = *(const bf16x8*)(vt + (vc * 16 + fr) * 72 + ks * 32 + fq * 8); \
                    S[vc] = __builtin_amdgcn_mfma_f32_16x16x32_bf16(A, B, S[vc], 0, 0, 0); } \
            } \
            const f32x4 sc = *(const f32x4*)(blE + 16 * w + fq * 4); \
            _Pragma("unroll") for (int vc = 0; vc < 4; ++vc) S[vc] = S[vc] * sc; \
        } \
        __syncthreads(); \
        _Pragma("unroll") for (int vc = 0; vc < 4; ++vc) { u32x2 o; o.x = pk2(S[vc][0], S[vc][1]); o.y = pk2(S[vc][2], S[vc][3]); *(u32x2*)(St + (vc * 16 + fr) * 136 + 16 * w + fq * 4) = o; } \
        { bool isl2; int tok2; size_t row2; GLA_ROW(ci, i, row2, tok2, isl2);     \
          bf16_t* od = obuf + row2 * 1024 + h * 256 + dvs * 64 + dg * 8; \
          const f32x4 o0_ = *(const f32x4*)(ostg + i * 68 + dg * 8), o1_ = *(const f32x4*)(ostg + i * 68 + dg * 8 + 4); \
          *(u32x4*)od = (u32x4){pk2(o0_[0], o0_[1]), pk2(o0_[2], o0_[3]), pk2(o1_[0], o1_[1]), pk2(o1_[2], o1_[3])}; } \
    } while (0)
    GS_LOAD(RA, reA, 0); GS_LOAD(RB, reB, 1);
    for (int ci = 0; ci < 68; ci += 2) { GS_BODY(RA, reA, ci); GS_BODY(RB, reB, ci + 1); }
    __syncthreads();
#undef GS_LOAD
#undef GS_BODY
}

constexpr int LR_BA = 0, LR_BX = 34816, LR_XCB = 69632, LR_XC32 = 87040, LR_CW = 120832, LR_END = 123392;
static_assert(LR_END <= LDS_BYTES, "lru lds");
constexpr size_t DO_PC0 = 0, DO_PC1 = 34 * MiB, DO_TOT = 68 * MiB;
__device__ __forceinline__ float expm1_neg(float x) {
    return (x > -0.02f) ? x * (1.f + x * (0.5f + x * (0.16666667f + x * 0.041666667f))) : __expf(x) - 1.f;
}
__device__ __forceinline__ void lru_pre(const Params& p, unsigned char* lds) {
    const int tid = threadIdx.x, lane = tid & 63, w = __builtin_amdgcn_readfirstlane(tid >> 6);
    const int dgi = blockIdx.x & 15, sub = blockIdx.x >> 4, nsub = (gridDim.x - dgi + 15) >> 4;
    const int g = dgi & 7, dir = dgi >> 3, c0 = 128 * g;
    bf16_t* Ba = (bf16_t*)(lds + LR_BA); bf16_t* Bx = (bf16_t*)(lds + LR_BX); bf16_t* xcb = (bf16_t*)(lds + LR_XCB);
    float* xc32 = (float*)(lds + LR_XC32); float* cw = (float*)(lds + LR_CW);
    const bf16_t* P = (const bf16_t*)(p.ws + WS_P);
    bf16_t* hbuf = (bf16_t*)(p.ws + (dir ? WS_HB : WS_HF));
    bf16_t* pcbuf = (bf16_t*)((unsigned char*)p.out + (dir ? DO_PC1 : DO_PC0));
    float* totP = (float*)((unsigned char*)p.out + DO_TOT); float* totH = totP + (size_t)8 * 68 * 1024;
    __syncthreads();
    { const u32x4* img = (const u32x4*)(p.ws + WS_LRUW + (size_t)(dir * 8 + g) * 2 * (128 * 136 * 2)); u32x4* dst = (u32x4*)Ba;
      for (int e = tid; e < 2 * 34816 / 16; e += 512) dst[e] = img[e]; }
    for (int e = tid; e < 640; e += 512) { const int j = e >> 7, c = e & 127; cw[e] = j < 4 ? p.conv_w[j * 1024 + c0 + c] : p.conv_b[c0 + c]; }
    __syncthreads();
    const int fr = lane & 15, fq = lane >> 4;
    const int ch = c0 + 16 * w + fr;
    const float ba = p.b_a[dir * 1024 + ch], bx = p.b_x[dir * 1024 + ch];
    const float ls8 = 8.f * logsigf_(p.lam[dir * 1024 + ch]);
    bf16x8 WA[4], WX[4];
#pragma unroll
    for (int ks = 0; ks < 4; ++ks) { WA[ks] = *(const bf16x8*)(Ba + (16 * w + fr) * 136 + ks * 32 + fq * 8); WX[ks] = *(const bf16x8*)(Bx + (16 * w + fr) * 136 + ks * 32 + fq * 8); }
    __syncthreads();
    bf16_t* hst = Ba; bf16_t* pst = Bx;
    const int i = tid >> 3, cgp = tid & 7;
    u32x4 rx[4][2];
#define LRU_LOAD(idx) do { const int b_ = (idx) / 68, ci_ = (idx) % 68; const bool isl_ = ci_ >= 4; const int cc_ = isl_ ? ci_ - 4 : ci_; const int n_ = isl_ ? SEQ : CTX; const int pos_ = cc_ * 64 + i; \
        const int tok_ = dir ? n_ - 1 - pos_ : pos_; const size_t rb_ = isl_ ? (size_t)b_ * SEQ : (size_t)MLAT + b_ * CTX; \
        _Pragma("unroll") for (int j = 0; j < 4; ++j) { const int tt_ = tok_ + j - 2; \
            if (tt_ >= 0 && tt_ < n_) { const bf16_t* pr = P + (rb_ + tt_) * NIN + C_XR + c0 + cgp * 16; rx[j][0] = *(const u32x4*)pr; rx[j][1] = *(const u32x4*)(pr + 8); } \
            else { rx[j][0] = (u32x4){0u, 0u, 0u, 0u}; rx[j][1] = (u32x4){0u, 0u, 0u, 0u}; } } } while (0)
    if (sub < 272) LRU_LOAD(sub);
    for (int idx = sub; idx < 272; idx += nsub) {
        const int b = idx / 68, ci = idx % 68;
        const bool isl = ci >= 4; const int cc = isl ? ci - 4 : ci; const int n = isl ? SEQ : CTX; const size_t rb = isl ? (size_t)b * SEQ : (size_t)MLAT + b * CTX;
        {
            float xc[16];
#pragma unroll
            for (int j = 0; j < 16; ++j) xc[j] = cw[4 * 128 + cgp * 16 + j];
#pragma unroll
            for (int t4 = 0; t4 < 4; ++t4) { float xv[16]; unpack8(rx[t4][0], xv); unpack8(rx[t4][1], xv + 8);
#pragma unroll
                for (int j = 0; j < 16; ++j) xc[j] += xv[j] * cw[t4 * 128 + cgp * 16 + j]; }
#pragma unroll
            for (int j4 = 0; j4 < 4; ++j4) *(f32x4*)(xc32 + i * 132 + cgp * 16 + 4 * j4) = (f32x4){xc[4 * j4], xc[4 * j4 + 1], xc[4 * j4 + 2], xc[4 * j4 + 3]};
            *(u32x4*)(xcb + i * 136 + cgp * 16) = (u32x4){pk2(xc[0], xc[1]), pk2(xc[2], xc[3]), pk2(xc[4], xc[5]), pk2(xc[6], xc[7])};
            *(u32x4*)(xcb + i * 136 + cgp * 16 + 8) = (u32x4){pk2(xc[8], xc[9]), pk2(xc[10], xc[11]), pk2(xc[12], xc[13]), pk2(xc[14], xc[15])};
            if (idx + nsub < 272) LRU_LOAD(idx + nsub);
        }
        __syncthreads();
        float hcar = 0.f, pcar = 1.f;
#pragma unroll
        for (int tt = 0; tt < 4; ++tt) {
            f32x4 ar = (f32x4){0.f, 0.f, 0.f, 0.f}, ai = (f32x4){0.f, 0.f, 0.f, 0.f};
#pragma unroll
            for (int ks = 0; ks < 4; ++ks) { const bf16x8 A = *(const bf16x8*)(xcb + (tt * 16 + fr) * 136 + ks * 32 + fq * 8);
                ar = __builtin_amdgcn_mfma_f32_16x16x32_bf16(A, WA[ks], ar, 0, 0, 0); ai = __builtin_amdgcn_mfma_f32_16x16x32_bf16(A, WX[ks], ai, 0, 0, 0); }
            float Pj[4], Hj[4];
            float Pl = 1.f, Hl = 0.f;
#pragma unroll
            for (int j = 0; j < 4; ++j) { const int ii = tt * 16 + fq * 4 + j;
                const float r = sigmoidf_(ar[j] + ba), ig = sigmoidf_(ai[j] + bx);
                const float la = r * ls8; const float a = __expf(la);
                const float xcv = xc32[ii * 132 + 16 * w + fr];
                const float u = sqrtf(fmaxf(-expm1_neg(2.f * la), 0.f)) * (ig * xcv);
                Pl = a * Pl; Hl = a * Hl + u; Pj[j] = Pl; Hj[j] = Hl; }
            float Pi = Pl, Hi = Hl;
            { const float Pp = __shfl_up(Pi, 16), Hp = __shfl_up(Hi, 16); if (fq >= 1) { Hi = Pi * Hp + Hi; Pi = Pp * Pi; } }
            { const float Pp = __shfl_up(Pi, 32), Hp = __shfl_up(Hi, 32); if (fq >= 2) { Hi = Pi * Hp + Hi; Pi = Pp * Pi; } }
            float Pe = __shfl_up(Pi, 16), He = __shfl_up(Hi, 16); if (fq == 0) { Pe = 1.f; He = 0.f; }
            const float sin_ = Pe * hcar + He, pin_ = Pe * pcar;
            const float Pt = __shfl(Pi, 48 + fr), Ht = __shfl(Hi, 48 + fr);
#pragma unroll
            for (int j = 0; j < 4; ++j) { const int ii = tt * 16 + fq * 4 + j; const int pos = cc * 64 + ii; const int tok = dir ? n - 1 - pos : pos;
                hst[ii * 136 + 16 * w + fr] = (bf16_t)f2bf(Pj[j] * sin_ + Hj[j]);
                pst[ii * 136 + 16 * w + fr] = (bf16_t)f2bf(Pj[j] * pin_); }
            hcar = Pt * hcar + Ht; pcar = Pt * pcar;
        }
        if (fq == 0) { const size_t to = ((size_t)(b * 2 + dir) * 68 + ci) * 1024 + ch; totP[to] = pcar; totH[to] = hcar; }
        __syncthreads();
        { const int pos = cc * 64 + i; const int tok = dir ? n - 1 - pos : pos; const size_t go = (rb + tok) * 1024 + c0 + cgp * 16;
          const u32x4 h0 = *(const u32x4*)(hst + i * 136 + cgp * 16), h1 = *(const u32x4*)(hst + i * 136 + cgp * 16 + 8);
          const u32x4 p0 = *(const u32x4*)(pst + i * 136 + cgp * 16), p1 = *(const u32x4*)(pst + i * 136 + cgp * 16 + 8);
          *(u32x4*)(hbuf + go) = h0; *(u32x4*)(hbuf + go + 8) = h1; *(u32x4*)(pcbuf + go) = p0; *(u32x4*)(pcbuf + go + 8) = p1; }
    }
#undef LRU_LOAD
}
__device__ __forceinline__ void lru_apply(const Params& p, int role) {
    const int tid = threadIdx.x;
    const int cg64 = role & 15, dir = (role >> 4) & 1, b = role >> 5;
    const int i = tid >> 3, c8 = tid & 7; const int ch = cg64 * 64 + c8 * 8;
    bf16_t* hbuf = (bf16_t*)(p.ws + (dir ? WS_HB : WS_HF));
    const bf16_t* pcbuf = (const bf16_t*)((const unsigned char*)p.out + (dir ? DO_PC1 : DO_PC0));
    const float* totP = (const float*)((const unsigned char*)p.out + DO_TOT) + (size_t)(b * 2 + dir) * 68 * 1024 + ch; const float* totH = totP + (size_t)8 * 68 * 1024;
    float cin[8];
#pragma unroll
    for (int j = 0; j < 8; ++j) cin[j] = 0.f;
    for (int c4 = 0; c4 < 68; c4 += 4) {
        u32x4 pw[4], hw[4]; f32x4 tp[4][2], th[4][2]; size_t off[4];
#pragma unroll
        for (int q = 0; q < 4; ++q) { const int ci = c4 + q;
            const bool isl = ci >= 4; const int cc = isl ? ci - 4 : ci; const int n = isl ? SEQ : CTX; const size_t rb = isl ? (size_t)b * SEQ : (size_t)MLAT + b * CTX;
            const int pos = cc * 64 + i; const int tok = dir ? n - 1 - pos : pos;
            off[q] = (rb + tok) * 1024 + ch;
            pw[q] = *(const u32x4*)(pcbuf + off[q]); hw[q] = *(const u32x4*)(hbuf + off[q]);
            tp[q][0] = *(const f32x4*)(totP + (size_t)ci * 1024); tp[q][1] = *(const f32x4*)(totP + (size_t)ci * 1024 + 4);
            th[q][0] = *(const f32x4*)(totH + (size_t)ci * 1024); th[q][1] = *(const f32x4*)(totH + (size_t)ci * 1024 + 4); }
#pragma unroll
        for (int q = 0; q < 4; ++q) {
            float pc[8], hl[8]; unpack8(pw[q], pc); unpack8(hw[q], hl);
            float hv[8];
#pragma unroll
            for (int j = 0; j < 8; ++j) hv[j] = pc[j] * cin[j] + hl[j];
            *(u32x4*)(hbuf + off[q]) = (u32x4){pk2(hv[0], hv[1]), pk2(hv[2], hv[3]), pk2(hv[4], hv[5]), pk2(hv[6], hv[7])};
            const float tpv[8] = {tp[q][0].x, tp[q][0].y, tp[q][0].z, tp[q][0].w, tp[q][1].x, tp[q][1].y, tp[q][1].z, tp[q][1].w};
            const float thv[8] = {th[q][0].x, th[q][0].y, th[q][0].z, th[q][0].w, th[q][1].x, th[q][1].y, th[q][1].z, th[q][1].w};
#pragma unroll
            for (int j = 0; j < 8; ++j) cin[j] = tpv[j] * cin[j] + thv[j];
        }
    }
}

__device__ __forceinline__ void phase_merge(const Params& p) {
    const int lane = threadIdx.x & 63, gw = blockIdx.x * 8 + (threadIdx.x >> 6), NGW = gridDim.x * 8;
    const bf16_t* P = (const bf16_t*)(p.ws + WS_P); const bf16_t* of = (const bf16_t*)(p.ws + WS_OF); const bf16_t* ob = (const bf16_t*)(p.ws + WS_OB);
    const bf16_t* hf = (const bf16_t*)(p.ws + WS_HF); const bf16_t* hb = (const bf16_t*)(p.ws + WS_HB); bf16_t* A = (bf16_t*)(p.ws + WS_A);
    for (int m = gw; m < MALL; m += NGW) {
        const bf16_t* pr = P + (size_t)m * NIN;
        u32x2 wf[4], wb[4], og[4], ha[4], hbv[4], yv[4];
#pragma unroll
        for (int h = 0; h < 4; ++h) { const int c = h * 256 + 4 * lane;
            wf[h] = *(const u32x2*)(of + (size_t)m * 1024 + c); wb[h] = *(const u32x2*)(ob + (size_t)m * 1024 + c); og[h] = *(const u32x2*)(pr + C_OG + c);
            ha[h] = *(const u32x2*)(hf + (size_t)m * 1024 + c); hbv[h] = *(const u32x2*)(hb + (size_t)m * 1024 + c); yv[h] = *(const u32x2*)(pr + C_YR + c); }
#pragma unroll
        for (int h = 0; h < 4; ++h) { const int c = h * 256 + 4 * lane;
            const f32x4 o = (f32x4){bflo(wf[h].x) + bflo(wb[h].x), bfhi(wf[h].x) + bfhi(wb[h].x), bflo(wf[h].y) + bflo(wb[h].y), bfhi(wf[h].y) + bfhi(wb[h].y)};
            const float ss = wave_sum((o.x * o.x + o.y * o.y) + (o.z * o.z + o.w * o.w));
            const float rstd = rsqrtf(ss * (1.f / 256.f) + EPS);
            const f32x4 gg = *(const f32x4*)(p.gla_g + c);
            const float r0 = o.x * rstd * gg.x * siluf_(bflo(og[h].x)), r1 = o.y * rstd * gg.y * siluf_(bfhi(og[h].x));
            const float r2 = o.z * rstd * gg.z * siluf_(bflo(og[h].y)), r3 = o.w * rstd * gg.w * siluf_(bfhi(og[h].y));
            *(u32x2*)(A + (size_t)m * D + c) = (u32x2){pk2(r0, r1), pk2(r2, r3)}; }
#pragma unroll
        for (int j = 0; j < 4; ++j) { const int c = 256 * j + 4 * lane;
            const u32x2 a = ha[j], bb = hbv[j], y = yv[j];
            const float r0 = (bflo(a.x) + bflo(bb.x)) * gelu_tanh(bflo(y.x)), r1 = (bfhi(a.x) + bfhi(bb.x)) * gelu_tanh(bfhi(y.x));
            const float r2 = (bflo(a.y) + bflo(bb.y)) * gelu_tanh(bflo(y.y)), r3 = (bfhi(a.y) + bfhi(bb.y)) * gelu_tanh(bfhi(y.y));
            *(u32x2*)(A + (size_t)m * D + 1024 + c) = (u32x2){pk2(r0, r1), pk2(r2, r3)}; }
    }
}

constexpr int NA_KT = 0, NA_VT = 34816, NA_PW = 71680, NA_RB = 108544, NA_END = 110592;
static_assert(NA_END <= LDS_BYTES, "na lds");
__device__ __forceinline__ void phase_na(const Params& p, unsigned char* lds) {
    const int tid = threadIdx.x, lane = tid & 63, w = __builtin_amdgcn_readfirstlane(tid >> 6), fr = lane & 15, fq = lane >> 4;
    bf16_t* KtB = (bf16_t*)(lds + NA_KT); bf16_t* vtB = (bf16_t*)(lds + NA_VT); bf16_t* Pw = (bf16_t*)(lds + NA_PW) + w * (32 * 72); float* rbt = (float*)(lds + NA_RB);
    const bf16_t* QK = (const bf16_t*)(p.ws + WS_P); const bf16_t* VTg = (const bf16_t*)(p.ws + WS_VT); bf16_t* O = (bf16_t*)(p.ws + WS_A);
    const int key = tid >> 3, part = tid & 7;
    const int vd = tid >> 2, vc4 = tid & 3;
    const float scale = 0.08838834764831845f * 1.4426950408889634f;
    for (int u = blockIdx.x; u < 1024; u += gridDim.x) {
        const int r4 = u & 15, h = (u >> 4) & 15, b = u >> 8, r0 = 4 * r4;
        const int rs_lo = min(max(r0 - 4, 0), 56), rs_hi = min(max(r0 - 1, 0), 56);
        const int ntile = 4 + (rs_hi + 8 - rs_lo);
        const int qr = r0 + (w >> 1), qc0 = 32 * (w & 1);
        const int rsq = min(max(qr - 4, 0), 56);
        __syncthreads();
        for (int e = tid; e < 465; e += 512) rbt[e] = p.rel_bias[h * 465 + e] * 1.4426950408889634f;
        bf16x8 aq[2][4];
#pragma unroll
        for (int mt = 0; mt < 2; ++mt) { const bf16_t* qp = QK + (size_t)(b * SEQ + qr * 64 + qc0 + 16 * mt + fr) * NQK + h * 128 + fq * 8;
#pragma unroll
            for (int ks = 0; ks < 4; ++ks) aq[mt][ks] = *(const bf16x8*)(qp + ks * 32); }
        f32x4 Oa[2][8];
#pragma unroll
        for (int mt = 0; mt < 2; ++mt)
#pragma unroll
            for (int dt = 0; dt < 8; ++dt) Oa[mt][dt] = (f32x4){0.f, 0.f, 0.f, 0.f};
        float mrow[2] = {-1e30f, -1e30f}, lrow[2] = {0.f, 0.f};
        u32x4 ra[4];
#define NA_LOAD(R, kt) do { const size_t row0_ = (kt) < 4 ? (size_t)MLAT + b * CTX + (kt) * 64 : (size_t)b * SEQ + (rs_lo + (kt) - 4) * 64; \
        const bf16_t* pk = QK + (row0_ + key) * NQK + D + h * 128 + part * 16; const bf16_t* pv = VTg + (size_t)(h * 128 + vd) * MALL + row0_ + vc4 * 16; \
        R[0] = *(const u32x4*)pk; R[1] = *(const u32x4*)(pk + 8); R[2] = *(const u32x4*)pv; R[3] = *(const u32x4*)(pv + 8); } while (0)
#define NA_WRITE(R, buf) do { bf16_t* kd = KtB + (buf) * (64 * 136) + key * 136 + part * 16; bf16_t* vdp = vtB + (buf) * (128 * 72) + vd * 72 + vc4 * 16; \
        *(u32x4*)kd = R[0]; *(u32x4*)(kd + 8) = R[1]; *(u32x4*)vdp = R[2]; *(u32x4*)(vdp + 8) = R[3]; } while (0)
        { u32x4 rn[4];
          NA_LOAD(ra, 0); NA_LOAD(rn, 1); NA_WRITE(ra, 0);
          ra[0] = rn[0]; ra[1] = rn[1]; ra[2] = rn[2]; ra[3] = rn[3]; }
        __syncthreads();
        for (int kt = 0; kt < ntile; ++kt) {
            if (kt + 1 < ntile) { NA_WRITE(ra, (kt + 1) & 1); if (kt + 2 < ntile) NA_LOAD(ra, kt + 2); }
            const bool band = kt >= 4; const int kr = rs_lo + kt - 4;
            if (!(band && (kr < rsq || kr >= rsq + 8))) {
                const bf16_t* Kt = KtB + (kt & 1) * (64 * 136); const bf16_t* vt = vtB + (kt & 1) * (128 * 72);
                f32x4 st[2][4];
                const int wlo0 = min(max(qc0 - 8, 0), 48), whi0 = min(max(qc0 + 7, 0), 48) + 16, wlo1 = min(max(qc0 + 8, 0), 48), whi1 = min(max(qc0 + 23, 0), 48) + 16;
#pragma unroll
                for (int nt = 0; nt < 4; ++nt) {
                    const bool act0 = !band || (16 * nt < whi0 && 16 * nt + 16 > wlo0), act1 = !band || (16 * nt < whi1 && 16 * nt + 16 > wlo1);
                    st[0][nt] = (f32x4){0.f, 0.f, 0.f, 0.f}; st[1][nt] = (f32x4){0.f, 0.f, 0.f, 0.f};
                    if (act0 || act1) {
                        bf16x8 Bk[4];
#pragma unroll
                        for (int ks = 0; ks < 4; ++ks) Bk[ks] = *(const bf16x8*)(Kt + (nt * 16 + fr) * 136 + ks * 32 + fq * 8);
#pragma unroll
                        for (int ks = 0; ks < 4; ++ks) {
                            if (act0) st[0][nt] = __builtin_amdgcn_mfma_f32_16x16x32_bf16(Bk[ks], aq[0][ks], st[0][nt], 0, 0, 0);
                            if (act1) st[1][nt] = __builtin_amdgcn_mfma_f32_16x16x32_bf16(Bk[ks], aq[1][ks], st[1][nt], 0, 0, 0); }
                    }
                }
                unsigned pk[2][4][2];
#pragma unroll
                for (int mt = 0; mt < 2; ++mt) {
                    __builtin_amdgcn_sched_barrier(0);
                    const int c = qc0 + 16 * mt + fr; const int cs = min(max(c - 8, 0), 48); const int wlo = mt ? wlo1 : wlo0, whi = mt ? whi1 : whi0;
                    float mx = -1e30f;
#pragma unroll
                    for (int nt = 0; nt < 4; ++nt) {
                        const bool act = !band || (16 * nt < whi && 16 * nt + 16 > wlo);
                        if (act) {
#pragma unroll
                            for (int j = 0; j < 4; ++j) { float v = st[mt][nt][j] * scale;
                                if (band) { const int kc = nt * 16 + fq * 4 + j; const bool valid = kc >= cs && kc < cs + 16; const int dci = min(max(kc - c + 15, 0), 30);
                                    v += rbt[(kr - qr + 7) * 31 + dci]; v = valid ? v : -1e30f; }
                                st[mt][nt][j] = v; mx = fmaxf(mx, v); }
                        }
                    }
                    mx = fmaxf(mx, __shfl_xor(mx, 16)); mx = fmaxf(mx, __shfl_xor(mx, 32));
                    const bool resc = !__all(mx - mrow[mt] <= 8.0f);
                    float mn = mrow[mt], alpha = 1.f;
                    if (resc) { mn = fmaxf(mrow[mt], mx); alpha = __builtin_amdgcn_exp2f(mrow[mt] - mn); mrow[mt] = mn; }
                    float ls = 0.f;
#pragma unroll
                    for (int nt = 0; nt < 4; ++nt) {
                        const bool act = !band || (16 * nt < whi && 16 * nt + 16 > wlo);
                        if (act) { const float p0 = __builtin_amdgcn_exp2f(st[mt][nt][0] - mn), p1 = __builtin_amdgcn_exp2f(st[mt][nt][1] - mn), p2 = __builtin_amdgcn_exp2f(st[mt][nt][2] - mn), p3 = __builtin_amdgcn_exp2f(st[mt][nt][3] - mn);
                            ls += (p0 + p1) + (p2 + p3); pk[mt][nt][0] = pk2(p0, p1); pk[mt][nt][1] = pk2(p2, p3); }
                        else { pk[mt][nt][0] = 0u; pk[mt][nt][1] = 0u; }
                    }
                    lrow[mt] = lrow[mt] * alpha + ls;
                    if (resc) {
#pragma unroll
                        for (int dt = 0; dt < 8; ++dt) Oa[mt][dt] = Oa[mt][dt] * alpha; }
                }
                __builtin_amdgcn_sched_barrier(0);
#pragma unroll
                for (int kk = 0; kk < 2; ++kk) {
                    const int ta = 2 * kk, tb = 2 * kk + 1;
                    const bf16x8 Bp0 = as_bf16x8((u32x4){pk[0][ta][0], pk[0][ta][1], pk[0][tb][0], pk[0][tb][1]}), Bp1 = as_bf16x8((u32x4){pk[1][ta][0], pk[1][ta][1], pk[1][tb][0], pk[1][tb][1]});
#pragma unroll
                    for (int dt = 0; dt < 8; ++dt) {
                        const u32x2 va = *(const u32x2*)(vt + (dt * 16 + fr) * 72 + 16 * ta + fq * 4), vb = *(const u32x2*)(vt + (dt * 16 + fr) * 72 + 16 * tb + fq * 4);
                        const bf16x8 Av = as_bf16x8((u32x4){va.x, va.y, vb.x, vb.y});
                        Oa[0][dt] = __builtin_amdgcn_mfma_f32_16x16x32_bf16(Av, Bp0, Oa[0][dt], 0, 0, 0);
                        Oa[1][dt] = __builtin_amdgcn_mfma_f32_16x16x32_bf16(Av, Bp1, Oa[1][dt], 0, 0, 0); }
                    __builtin_amdgcn_sched_group_barrier(0x100, 8, 0);
#pragma unroll
                    for (int q = 0; q < 4; ++q) { __builtin_amdgcn_sched_group_barrier(0x008, 2, 0); __builtin_amdgcn_sched_group_barrier(0x100, 2, 0); }
                    __builtin_amdgcn_sched_group_barrier(0x008, 8, 0);
                    __builtin_amdgcn_sched_barrier(0);
                }
            }
            __syncthreads();
        }
        { bf16_t* ost = KtB + w * (32 * 136);
#pragma unroll
          for (int mt = 0; mt < 2; ++mt) {
            float l = lrow[mt]; l += __shfl_xor(l, 16); l += __shfl_xor(l, 32); const float inv = 1.f / l;
#pragma unroll
            for (int dt = 0; dt < 8; ++dt) *(u32x2*)(ost + (mt * 16 + fr) * 136 + dt * 16 + fq * 4) = (u32x2){pk2(Oa[mt][dt][0] * inv, Oa[mt][dt][1] * inv), pk2(Oa[mt][dt][2] * inv, Oa[mt][dt][3] * inv)}; }
          asm volatile("s_waitcnt lgkmcnt(0)" ::: "memory");
          const int q = lane >> 1, hf = lane & 1;
          bf16_t* op = O + (size_t)(b * SEQ + qr * 64 + qc0 + q) * D + h * 128 + hf * 64;
#pragma unroll
          for (int e = 0; e < 8; ++e) *(u32x4*)(op + e * 8) = *(const u32x4*)(ost + q * 136 + hf * 64 + e * 8); }
#undef NA_LOAD
#undef NA_WRITE
    }
    __syncthreads();
}

__device__ __forceinline__ void phase_final(const Params& p) {
    const int lane = threadIdx.x & 63, gw = blockIdx.x * 8 + (threadIdx.x >> 6), NGW = gridDim.x * 8;
    f32x4 gg[8];
#pragma unroll
    for (int j = 0; j < 8; ++j) gg[j] = *(const f32x4*)(p.fin_g + 256 * j + 4 * lane);
    int m = gw;
    for (; m + NGW < MLAT; m += 2 * NGW) {
        float* x0 = p.out + (size_t)m * D; float* x1 = p.out + (size_t)(m + NGW) * D;
        f32x4 v0[8], v1[8]; float s0 = 0.f, s1 = 0.f;
#pragma unroll
        for (int j = 0; j < 8; ++j) { v0[j] = *(const f32x4*)(x0 + 256 * j + 4 * lane); v1[j] = *(const f32x4*)(x1 + 256 * j + 4 * lane); }
#pragma unroll
        for (int j = 0; j < 8; ++j) { s0 += (v0[j].x * v0[j].x + v0[j].y * v0[j].y) + (v0[j].z * v0[j].z + v0[j].w * v0[j].w); s1 += (v1[j].x * v1[j].x + v1[j].y * v1[j].y) + (v1[j].z * v1[j].z + v1[j].w * v1[j].w); }
        const float r0 = rsqrtf(wave_sum(s0) * (1.f / D) + EPS), r1 = rsqrtf(wave_sum(s1) * (1.f / D) + EPS);
#pragma unroll
        for (int j = 0; j < 8; ++j) { *(f32x4*)(x0 + 256 * j + 4 * lane) = v0[j] * r0 * gg[j]; *(f32x4*)(x1 + 256 * j + 4 * lane) = v1[j] * r1 * gg[j]; }
    }
    for (; m < MLAT; m += NGW) {
        float* xr = p.out + (size_t)m * D;
        f32x4 v[8]; float ss = 0.f;
#pragma unroll
        for (int j = 0; j < 8; ++j) { v[j] = *(const f32x4*)(xr + 256 * j + 4 * lane); ss += (v[j].x * v[j].x + v[j].y * v[j].y) + (v[j].z * v[j].z + v[j].w * v[j].w); }
        const float rstd = rsqrtf(wave_sum(ss) * (1.f / D) + EPS);
#pragma unroll
        for (int j = 0; j < 8; ++j) *(f32x4*)(xr + 256 * j + 4 * lane) = v[j] * rstd * gg[j];
    }
}

#define XB_TMO      128
#define XB_XCNT(j)  (256  + 64 * (j))
#define XB_XSUB(j)  (1280 + 64 * (j))
#define XB_XGEN(j)  (2304 + 64 * (j))
#define XB_TOP      3328
#define XB_TOPGEN   3392
#define XCD_BAR_WORDS 3456
#define XB_SPIN_CAP (1u << 18)
__device__ __forceinline__ unsigned xb_ld(unsigned* p)              { return __hip_atomic_load(p, __ATOMIC_RELAXED, __HIP_MEMORY_SCOPE_AGENT); }
__device__ __forceinline__ unsigned xb_add(unsigned* p, unsigned v) { return __hip_atomic_fetch_add(p, v, __ATOMIC_RELAXED, __HIP_MEMORY_SCOPE_AGENT); }
__device__ __forceinline__ unsigned xb_xcc_id() { return (unsigned)__builtin_amdgcn_s_getreg((3 << 11) | 20) & 0xFu; }
#define XB_SPIN(cond, bar) do { unsigned _sp = 0; while (cond) { __builtin_amdgcn_s_sleep(1); \
    if ((++_sp & 255u) == 0u) { if (xb_ld(&(bar)[XB_TMO])) break; if (_sp > XB_SPIN_CAP) { atomicAdd(&(bar)[XB_TMO], 1u); break; } } } } while (0)
struct XcdBarrier { unsigned* bar; unsigned x; volatile LAS unsigned* st; };
__device__ __forceinline__ XcdBarrier xcd_barrier_post(unsigned* bar, volatile LAS unsigned* st) {
    XcdBarrier b; b.bar = bar; b.x = xb_xcc_id(); b.st = st;
    if (threadIdx.x == 0) (void)xb_add(&bar[XB_XCNT(b.x)], 1u);
    return b;
}
__device__ __forceinline__ void xcd_barrier_complete(unsigned* bar, unsigned x, unsigned& nloc, unsigned& nx) {
    const unsigned G = gridDim.x * gridDim.y * gridDim.z;
    unsigned sum, cnt, mine, sp = 0u;
    for (;;) {
        sum = 0u; cnt = 0u; mine = 0u;
#pragma unroll
        for (unsigned j = 0; j < 16; ++j) { const unsigned c = xb_ld(&bar[XB_XCNT(j)]); sum += c; cnt += (c > 0u) ? 1u : 0u; mine = (j == x) ? c : mine; }
        if (sum == G) break;
        __builtin_amdgcn_s_sleep(1);
        if ((++sp & 255u) == 0u) { if (xb_ld(&bar[XB_TMO])) break; if (sp > XB_SPIN_CAP) { atomicAdd(&bar[XB_TMO], 1u); break; } }
    }
    nloc = mine > 0u ? mine : 1u; nx = cnt > 0u ? cnt : 1u;
}
__device__ __forceinline__ void xcd_barrier(const XcdBarrier& b) {
    asm volatile("s_waitcnt vmcnt(0)" ::: "memory");
    __syncthreads();
    if (threadIdx.x == 0) {
        unsigned* bar = b.bar;
        __builtin_amdgcn_s_waitcnt(0);
        unsigned nloc = b.st[0], nx = b.st[1];
        if (nloc == 0u) { xcd_barrier_complete(bar, b.x, nloc, nx); b.st[0] = nloc; b.st[1] = nx; }
        const unsigned old = xb_add(&bar[XB_XSUB(b.x)], 1u);
        const unsigned gen = old / nloc;
        if (old + 1u == (gen + 1u) * nloc) {
            __builtin_amdgcn_fence(__ATOMIC_RELEASE, "agent");
            asm volatile("s_waitcnt vmcnt(0)" ::: "memory");
            const unsigned og = xb_add(&bar[XB_TOP], 1u);
            const unsigned tg = og / nx;
            if (og + 1u == (tg + 1u) * nx) xb_add(&bar[XB_TOPGEN], 1u);
            else XB_SPIN(xb_ld(&bar[XB_TOPGEN]) == tg, bar);
            __builtin_amdgcn_fence(__ATOMIC_ACQUIRE, "agent");
            xb_add(&bar[XB_XGEN(b.x)], 1u);
            asm volatile("s_waitcnt vmcnt(0)" ::: "memory");
        } else {
            XB_SPIN(xb_ld(&bar[XB_XGEN(b.x)]) == gen, bar);
            __builtin_amdgcn_fence(__ATOMIC_ACQUIRE, "agent");
            asm volatile("s_waitcnt vmcnt(0)" ::: "memory");
        }
    }
    __syncthreads();
}

constexpr int N_PHASES = 17;
#ifndef ONLYP
#define ONLYP -1
#endif
#define PH(k) (ONLYP < 0 || ONLYP == (k))
#ifndef REPP
#define REPP -1
#endif
#define NREP(k) ((REPP == (k)) ? 2 : 1)
__device__ __forceinline__ void run_gemm_store(const Params& p, LAS unsigned char* ldsl, const int ph) {
    unsigned char* ws = p.ws; const int l1 = ph >= 9; const int Mrows = ph >= 12 ? MLAT : MALL;
    const bf16_t* A = (const bf16_t*)(ws + WS_A);
    pg8::Gemm g{D}; pg8::SegOrder S; S.init(D, gridDim.x, blockIdx.x);
    pg8::EpiBf16 E{(bf16_t*)(ws + WS_P), NIN, (bf16_t*)(ws + WS_VT), MALL, 0};
    if (ph == 2) { S.add(A, ws + WS_WIN, MALL / 256, NIN / 256, 1, D / 64, 0); S.add(ws + WS_WV0, A, 1024 / 256, MALL / 256, 1, D / 64, 1); }
    else if (ph == 10) { E.ldc0 = NQK; S.add(A, ws + WS_WQKV, MALL / 256, NQK / 256, 1, D / 64, 0); S.add((const bf16_t*)(ws + WS_WQKV) + (size_t)NQK * D, A, D / 256, MALL / 256, 1, D / 64, 1); }
    else { E.O0 = (bf16_t*)(ws + WS_H); E.ldc0 = DFF; E.ACT = 1; S.add(A, (const bf16_t*)(ws + WS_WUP) + (size_t)l1 * D * DFF, Mrows / 256, DFF / 256, 1, D / 64, 0); }
    pg8::gemm_phase<pg8::EpiBf16, pg8::SegOrder, true, true>(ldsl, g, S, E);
}
__device__ __forceinline__ void run_gemm_resid(const Params& p, LAS unsigned char* ldsl, const int ph) {
    unsigned char* ws = p.ws; const int l1 = ph >= 9;
    const float* modl = (const float*)(ws + WS_MODV) + (size_t)l1 * 5 * (6 * D);
    float* xcb = (float*)(ws + WS_XC);
    const bool dn = (ph == 8 || ph == 15);
    const int K = dn ? DFF : D;
    const bf16_t* A = dn ? (const bf16_t*)(ws + WS_H) : (const bf16_t*)(ws + WS_A);
    const bf16_t* Bt = dn ? (const bf16_t*)(ws + WS_WDN) + (size_t)l1 * D * DFF : (ph == 5 ? (const bf16_t*)(ws + WS_WOUT) : (const bf16_t*)(ws + WS_WNO));
    pg8::Gemm g{K}; pg8::SegOrder S; S.init(K, gridDim.x, blockIdx.x);
    S.add(A, Bt, MLAT / 256, D / 256, 1, K / 64, 0);
    if (!l1) S.add(A + (size_t)MLAT * K, Bt, MCTX / 256, D / 256, 8, K / 64 / 8, 1);
    pg8::EpiResid E{ph == 5 ? p.x : p.out, p.out, (float*)(ws + WS_PART), modl + (dn ? 5 : 2) * D};
    pg8::gemm_phase<pg8::EpiResid, pg8::SegOrder, true, true>(ldsl, g, S, E);
}
__global__ void __launch_bounds__(512, 2) fwd_megakernel(Params p) {
    extern __shared__ __attribute__((aligned(16))) unsigned char lds[];
    cg::grid_group grid = cg::this_grid();
    LAS unsigned char* ldsl = (LAS unsigned char*)lds;
    const int lo = p.ph_lo, hi = p.ph_hi;
    float* xcb = (float*)(p.ws + WS_XC);
#define IN(k) (lo <= (k) && (k) < hi)
    if (threadIdx.x < 2) ((volatile LAS unsigned*)(ldsl + LDS_BYTES - 64))[threadIdx.x] = 0u;
    __syncthreads();
    const XcdBarrier xb = xcd_barrier_post((unsigned*)(p.ws + WS_BAR), (volatile LAS unsigned*)(ldsl + LDS_BYTES - 64));
    if (p.ph_hi > 1000) grid.sync();
#define GSYNC() xcd_barrier(xb)
#define SEAM(k) do { if (IN(k) && IN((k) + 1)) GSYNC(); } while (0)
    if (IN(0)) { for (int rep_ = 0; rep_ < NREP(0); ++rep_) { if (rep_) GSYNC(); if (PH(0)) phase_mod(p, lds, 0, 0, gridDim.x); } } SEAM(0);
    if (IN(1)) { for (int rep_ = 0; rep_ < NREP(1); ++rep_) { if (rep_) GSYNC(); if (PH(1)) { phase_convert(p, lds, 0, 0, gridDim.x); phase_modulate(p, p.x, p.ctx, p.norm1_g, 0, 0, MALL, -1, 0); } } } SEAM(1);
    if (IN(2)) { for (int rep_ = 0; rep_ < NREP(2); ++rep_) { if (rep_) GSYNC(); if (PH(2)) run_gemm_store(p, ldsl, 2); } } SEAM(2);
    if (IN(3)) { for (int rep_ = 0; rep_ < NREP(3); ++rep_) { if (rep_) GSYNC(); if (PH(3)) { gla_pre(p, lds); lru_pre(p, lds); GSYNC(); for (int role = blockIdx.x; role < 256; role += gridDim.x) { if (role < 128) gla_seq(p, lds, role); else lru_apply(p, role - 128); }
        { const int wb0 = gridDim.x >= 256 ? 128 : 0, nwb = gridDim.x - wb0; if ((int)blockIdx.x >= wb0) { phase_convert(p, lds, 1, wb0, nwb); phase_mod(p, lds, 1, wb0, nwb); } } } } } SEAM(3);
    if (IN(4)) { for (int rep_ = 0; rep_ < NREP(4); ++rep_) { if (rep_) GSYNC(); if (PH(4)) phase_merge(p); } } SEAM(4);
    if (IN(5)) { for (int rep_ = 0; rep_ < NREP(5); ++rep_) { if (rep_) GSYNC(); if (PH(5)) run_gemm_resid(p, ldsl, 5); } } SEAM(5);
    if (IN(6)) { for (int rep_ = 0; rep_ < NREP(6); ++rep_) { if (rep_) GSYNC(); if (PH(6)) phase_modulate(p, p.out, p.ctx, p.norm2_g, 0, 1, MALL, 2, 0); } } SEAM(6);
    if (IN(7)) { for (int rep_ = 0; rep_ < NREP(7); ++rep_) { if (rep_) GSYNC(); if (PH(7)) run_gemm_store(p, ldsl, 7); } } SEAM(7);
    if (IN(8)) { for (int rep_ = 0; rep_ < NREP(8); ++rep_) { if (rep_) GSYNC(); if (PH(8)) run_gemm_resid(p, ldsl, 8); } } SEAM(8);
    if (IN(9)) { for (int rep_ = 0; rep_ < NREP(9); ++rep_) { if (rep_) GSYNC(); if (PH(9)) phase_modulate(p, p.out, xcb, p.norm1_g + D, 1, 0, MALL, 5, 0); } } SEAM(9);
    if (IN(10)) { for (int rep_ = 0; rep_ < NREP(10); ++rep_) { if (rep_) GSYNC(); if (PH(10)) run_gemm_store(p, ldsl, 10); } } SEAM(10);
    if (IN(11)) { for (int rep_ = 0; rep_ < NREP(11); ++rep_) { if (rep_) GSYNC(); if (PH(11)) phase_na(p, lds); } } SEAM(11);
    if (IN(12)) { for (int rep_ = 0; rep_ < NREP(12); ++rep_) { if (rep_) GSYNC(); if (PH(12)) run_gemm_resid(p, ldsl, 12); } } SEAM(12);
    if (IN(13)) { for (int rep_ = 0; rep_ < NREP(13); ++rep_) { if (rep_) GSYNC(); if (PH(13)) phase_modulate(p, p.out, xcb, p.norm2_g + D, 1, 1, MLAT, -1, 0); } } SEAM(13);
    if (IN(14)) { for (int rep_ = 0; rep_ < NREP(14); ++rep_) { if (rep_) GSYNC(); if (PH(14)) run_gemm_store(p, ldsl, 14); } } SEAM(14);
    if (IN(15)) { for (int rep_ = 0; rep_ < NREP(15); ++rep_) { if (rep_) GSYNC(); if (PH(15)) run_gemm_resid(p, ldsl, 15); } } SEAM(15);
    if (IN(16)) { for (int rep_ = 0; rep_ < NREP(16); ++rep_) { if (rep_) GSYNC(); if (PH(16)) phase_final(p); } }
#undef IN
#undef SEAM
}

extern "C" void kernel_launch(void* const* d_in, const int* in_sizes, int n_in, void* d_out, int out_size, void* d_ws, size_t ws_size, hipStream_t stream) {
    static int grid = 0;
    if (grid == 0) {
        if (n_in != 26 || out_size != MLAT * D || ws_size < WS_END) { fprintf(stderr, "kernel_launch: unexpected shapes (n_in %d out %d ws %zu)\n", n_in, out_size, ws_size); grid = -1; return; }
        int dev = 0, cus = 0, per_cu = 0;
        hipGetDevice(&dev); hipDeviceGetAttribute(&cus, hipDeviceAttributeMultiprocessorCount, dev);
        hipFuncSetAttribute((const void*)fwd_megakernel, hipFuncAttributeMaxDynamicSharedMemorySize, LDS_BYTES);
        hipOccupancyMaxActiveBlocksPerMultiprocessor(&per_cu, (const void*)fwd_megakernel, 512, LDS_BYTES);
        if (per_cu < 1) { fprintf(stderr, "kernel_launch: occupancy query returned %d\n", per_cu); per_cu = 1; }
        grid = cus * 1;
        (void)hipGetLastError();
    }
    if (grid < 0) return;
    if (hipMemsetAsync((char*)d_ws + WS_BAR, 0, 16384, stream) != hipSuccess) { fprintf(stderr, "kernel_launch: memset of the barrier words failed\n"); return; }
    Params p{};
    const float** f = (const float**)&p;
    for (int i = 0; i < 26; ++i) f[i] = (const float*)d_in[i];
    p.out = (float*)d_out; p.ws = (unsigned char*)d_ws; p.ph_lo = 0; p.ph_hi = N_PHASES;
    void* args[] = {&p};
    hipError_t e = hipLaunchCooperativeKernel((const void*)fwd_megakernel, dim3(grid), dim3(512), args, LDS_BYTES, stream);
    if (e != hipSuccess) fprintf(stderr, "cooperative launch failed: %s (grid %d)\n", hipGetErrorString(e), grid);
}
```
